# Optimizing an MI355X kernel written in HIP

```python
import jax, jax.numpy as jnp
from jax import lax
import numpy as np

D_MODEL = 1024
BATCH = 16
SEQ = 2048
DEPTH = 2
DEC_BATCH = 2
DEC_SEQ = 8192
PAST_LEN = 128

N_MIXERS = 2
N_POOL_LAYERS = (DEPTH + 1) // 2
N_ATTN_LAYERS = DEPTH // 2
EPS = 1e-6
POOL_WINDOWS = (2, 4, 8, 16)
N_GROUPS = len(POOL_WINDOWS)
GROUP = D_MODEL // N_GROUPS
HEAD_DIM = 64
N_HEADS = D_MODEL // HEAD_DIM
N_KV = 4
GQA_GROUP = N_HEADS // N_KV
WINDOW = 128
BLOCK = 128
KEYS = BLOCK + 2 * WINDOW
ROPE_THETA = 10000.0
N_MEM = 256
X_HEADS = 4
X_HEAD_DIM = D_MODEL // X_HEADS
D_FF = 4 * D_MODEL

kernel_name = "hybrid_pool_window_gqa_memory_encoder"


def rmsnorm(x, g):
    xf = x.astype(jnp.float32)
    y = xf * lax.rsqrt(jnp.mean(xf * xf, axis=-1, keepdims=True) + EPS)
    return (y * g.astype(jnp.float32)).astype(x.dtype)


def rope_tables(seq_len):
    inv_freq = ROPE_THETA ** (-jnp.arange(0, HEAD_DIM, 2, dtype=jnp.float32) / HEAD_DIM)
    ang = jnp.arange(seq_len, dtype=jnp.float32)[:, None] * inv_freq[None, :]
    return jnp.cos(ang), jnp.sin(ang)


def apply_rope(x, cos, sin):
    xf = x.astype(jnp.float32)
    x1, x2 = jnp.split(xf, 2, axis=-1)
    c = cos[None, :, None, :]
    s = sin[None, :, None, :]
    return jnp.concatenate([x1 * c - x2 * s, x2 * c + x1 * s], axis=-1).astype(x.dtype)


def pool_mixer(h, w_pool, scale):
    B, S, D = h.shape
    hf = h.astype(jnp.float32)
    cs = jnp.concatenate([jnp.zeros((B, 1, D), jnp.float32), jnp.cumsum(hf, axis=1)], axis=1)
    t = jnp.arange(S)
    pooled = []
    for g, w in enumerate(POOL_WINDOWS):
        lo = jnp.clip(t - w // 2, 0, S)
        hi = jnp.clip(t + w // 2, 0, S)
        count = (hi - lo).astype(jnp.float32)
        seg = cs[:, :, g * GROUP:(g + 1) * GROUP]
        total = jnp.take(seg, hi, axis=1) - jnp.take(seg, lo, axis=1)
        pooled.append(total / count[None, :, None])
    diff = jnp.concatenate(pooled, axis=-1) - hf
    y = jnp.einsum("bsgc,gcd->bsgd", diff.reshape(B, S, N_GROUPS, GROUP), w_pool.astype(jnp.float32))
    y = y.reshape(B, S, D) * scale.astype(jnp.float32)
    return y.astype(h.dtype)


def window_attention(h, w_qkv, w_o, sinks, cos, sin):
    B, S, _ = h.shape
    nb = S // BLOCK
    qkv = h @ w_qkv
    q = qkv[..., :N_HEADS * HEAD_DIM].reshape(B, S, N_HEADS, HEAD_DIM)
    k = qkv[..., N_HEADS * HEAD_DIM:(N_HEADS + N_KV) * HEAD_DIM].reshape(B, S, N_KV, HEAD_DIM)
    v = qkv[..., (N_HEADS + N_KV) * HEAD_DIM:].reshape(B, S, N_KV, HEAD_DIM)
    q = apply_rope(q, cos, sin) * (HEAD_DIM ** -0.5)
    k = apply_rope(k, cos, sin)
    pad = ((0, 0), (WINDOW, WINDOW), (0, 0), (0, 0))
    kp = jnp.pad(k, pad)
    vp = jnp.pad(v, pad)
    qb = q.reshape(B, nb, BLOCK, N_KV, GQA_GROUP, HEAD_DIM).transpose(1, 0, 2, 3, 4, 5)
    r = jnp.arange(BLOCK)
    c = jnp.arange(KEYS)
    sink = sinks.astype(jnp.float32).reshape(N_KV, GQA_GROUP)

    def block(args):
        i, qi = args
        ki = lax.dynamic_slice_in_dim(kp, i * BLOCK, KEYS, axis=1)
        vi = lax.dynamic_slice_in_dim(vp, i * BLOCK, KEYS, axis=1)
        s = jnp.einsum("bqkgd,bskd->bkgqs", qi, ki).astype(jnp.float32)
        qpos = i * BLOCK + r
        kpos = i * BLOCK - WINDOW + c
        mask = (jnp.abs(kpos[None, :] - qpos[:, None]) <= WINDOW) & (kpos[None, :] >= 0) & (kpos[None, :] < S)
        s = jnp.where(mask[None, None, None], s, -1e30)
        sink_col = jnp.broadcast_to(sink[None, :, :, None, None], s.shape[:-1] + (1,))
        p = jax.nn.softmax(jnp.concatenate([s, sink_col], axis=-1), axis=-1)[..., :-1]
        o = jnp.einsum("bkgqs,bskd->bqkgd", p.astype(vi.dtype), vi)
        return o.reshape(B, BLOCK, N_HEADS * HEAD_DIM)

    o = lax.map(block, (jnp.arange(nb), qb))
    o = o.transpose(1, 0, 2, 3).reshape(B, S, N_HEADS * HEAD_DIM)
    return o @ w_o


def memory_attention(h, mem_n, w_q, w_kv, w_o):
    B, S, _ = h.shape
    q = (h @ w_q).reshape(B, S, X_HEADS, X_HEAD_DIM) * (X_HEAD_DIM ** -0.5)
    kv = mem_n @ w_kv
    k = kv[..., :D_MODEL].reshape(B, N_MEM, X_HEADS, X_HEAD_DIM)
    v = kv[..., D_MODEL:].reshape(B, N_MEM, X_HEADS, X_HEAD_DIM)
    s = jnp.einsum("bshd,bmhd->bhsm", q, k).astype(jnp.float32)
    p = jax.nn.softmax(s, axis=-1).astype(v.dtype)
    o = jnp.einsum("bhsm,bmhd->bshd", p, v).reshape(B, S, D_MODEL)
    return o @ w_o


def sq_relu_mlp(h, w_up, w_down):
    u = jax.nn.relu(h @ w_up)
    return (u * u) @ w_down


def trunk(x, mem, norm_mix, pool_w, pool_scale, attn_qkv, attn_o, attn_sink,
          norm_x, norm_mem, x_wq, x_wkv, x_wo, norm_mlp, w_up, w_down, norm_final):
    S = x.shape[1]
    cos, sin = rope_tables(S)
    for i in range(DEPTH):
        j = i // N_MIXERS
        hn = rmsnorm(x, norm_mix[i])
        if i % N_MIXERS == 0:
            x = x + pool_mixer(hn, pool_w[j], pool_scale[j])
        else:
            x = x + window_attention(hn, attn_qkv[j], attn_o[j], attn_sink[j], cos, sin)
        x = x + memory_attention(rmsnorm(x, norm_x[i]), rmsnorm(mem, norm_mem[i]), x_wq[i], x_wkv[i], x_wo[i])
        x = x + sq_relu_mlp(rmsnorm(x, norm_mlp[i]), w_up[i], w_down[i])
    return rmsnorm(x, norm_final)


def setup_inputs(seed: int = 0) -> dict:
    key = jax.random.key(seed)
    ks = jax.random.split(key, 24)
    f32 = jnp.float32

    def nrm(k, shape, scale):
        return jax.random.normal(k, shape, f32) * scale

    def gain(k, shape):
        return 1.0 + 0.05 * jax.random.normal(k, shape, f32)

    D = D_MODEL
    return {
        "x_prompt": nrm(ks[0], (BATCH, SEQ, D), 1.0),
        "x_sample": nrm(ks[1], (DEC_BATCH, DEC_SEQ, D), 1.0),
        "mem_prompt": nrm(ks[2], (BATCH, N_MEM, D), 1.0),
        "mem_sample": nrm(ks[3], (DEC_BATCH, N_MEM, D), 1.0),
        "norm_mix": gain(ks[4], (DEPTH, D)),
        "pool_w": nrm(ks[5], (N_POOL_LAYERS, N_GROUPS, GROUP, GROUP), GROUP ** -0.5),
        "pool_scale": 0.5 + 0.1 * jax.random.normal(ks[6], (N_POOL_LAYERS, D), f32),
        "attn_qkv": nrm(ks[7], (N_ATTN_LAYERS, D, (N_HEADS + 2 * N_KV) * HEAD_DIM), D ** -0.5),
        "attn_o": nrm(ks[8], (N_ATTN_LAYERS, N_HEADS * HEAD_DIM, D), (N_HEADS * HEAD_DIM) ** -0.5),
        "attn_sink": nrm(ks[9], (N_ATTN_LAYERS, N_HEADS), 0.5),
        "norm_x": gain(ks[10], (DEPTH, D)),
        "norm_mem": gain(ks[11], (DEPTH, D)),
        "x_wq": nrm(ks[12], (DEPTH, D, D), D ** -0.5),
        "x_wkv": nrm(ks[13], (DEPTH, D, 2 * D), D ** -0.5),
        "x_wo": nrm(ks[14], (DEPTH, D, D), D ** -0.5),
        "norm_mlp": gain(ks[15], (DEPTH, D)),
        "w_up": nrm(ks[16], (DEPTH, D, D_FF), D ** -0.5),
        "w_down": nrm(ks[17], (DEPTH, D_FF, D), D_FF ** -0.5),
        "norm_final": gain(ks[18], (D,)),
    }


def reference(x_prompt, x_sample, mem_prompt, mem_sample, norm_mix, pool_w, pool_scale,
              attn_qkv, attn_o, attn_sink, norm_x, norm_mem, x_wq, x_wkv, x_wo,
              norm_mlp, w_up, w_down, norm_final):
    y_prompt = trunk(x_prompt, mem_prompt, norm_mix, pool_w, pool_scale, attn_qkv, attn_o, attn_sink,
                     norm_x, norm_mem, x_wq, x_wkv, x_wo, norm_mlp, w_up, w_down, norm_final)
    y_sample = trunk(x_sample, mem_sample, norm_mix, pool_w, pool_scale, attn_qkv, attn_o, attn_sink,
                     norm_x, norm_mem, x_wq, x_wkv, x_wo, norm_mlp, w_up, w_down, norm_final)
    return (y_prompt, y_sample)
```

```cpp
#include <hip/hip_runtime.h>
#include <hip/hip_cooperative_groups.h>
#include <cstdio>
#include <cstdint>
namespace cg = cooperative_groups;

#ifndef ONE_LAUNCH
#define ONE_LAUNCH 1
#endif

#define LAS __attribute__((address_space(3)))
typedef unsigned short bf16_t;
typedef short bf16x8 __attribute__((ext_vector_type(8)));
typedef float f32x4 __attribute__((ext_vector_type(4)));
typedef float f32x2 __attribute__((ext_vector_type(2)));
typedef float f32x16 __attribute__((ext_vector_type(16)));
typedef unsigned u32x4 __attribute__((ext_vector_type(4)));
typedef unsigned u32x2 __attribute__((ext_vector_type(2)));
typedef __bf16 bf16x2_t __attribute__((ext_vector_type(2)));

constexpr int D = 1024, FF = 4096, T = 49152, TP = 32768, SEQP = 2048, SEQS = 8192, NMEMROWS = 4608, NQKV = 1536;
constexpr float EPS = 1e-6f, LOG2E = 1.4426950408889634f;
constexpr int NWAVES = 8, NTHR = 512;

constexpr size_t MiB = 1u << 20;
constexpr size_t WS_PW = 1 * MiB, WS_WQKV = 2 * MiB, WS_WAO = 5 * MiB, WS_WXQ = 7 * MiB, WS_WXKV = 11 * MiB, WS_WXO = 19 * MiB, WS_WUP = 23 * MiB, WS_WDN = 39 * MiB;
constexpr size_t WS_ROPE = 55 * MiB, WS_RSTD0 = 57 * MiB, WS_SSP = 58 * MiB, WS_SSPM = 61 * MiB, WS_MB = 62 * MiB, WS_KM = 71 * MiB, WS_VMT = 89 * MiB, WS_XB = 108 * MiB;
constexpr size_t WS_BIG = 204 * MiB, WS_QB = WS_BIG, WS_KW = WS_BIG + 96 * MiB, WS_VT = WS_BIG + 120 * MiB, WS_H0 = WS_BIG, WS_H1 = WS_BIG + 128 * MiB, WS_END = WS_BIG + 256 * MiB;

__device__ __forceinline__ unsigned pk_bf16(float lo, float hi) { f32x2 v = {lo, hi}; bf16x2_t b = __builtin_convertvector(v, bf16x2_t); return __builtin_bit_cast(unsigned, b); }
__device__ __forceinline__ float rstd_from(const float* p) {
    const f32x4 a = *(const f32x4*)p, b = *(const f32x4*)(p + 4), c = *(const f32x4*)(p + 8), d = *(const f32x4*)(p + 12);
    const f32x4 s = (a + b) + (c + d);
    return rsqrtf(((s[0] + s[1]) + (s[2] + s[3])) * (1.0f / D) + EPS);
}
__device__ __forceinline__ float wave_sum(float v) {
#pragma unroll
    for (int o = 1; o < 64; o <<= 1) v += __shfl_xor(v, o);
    return v;
}

namespace pg8 {
constexpr int BM = 256, BK = 64, HALF = 128, HTB = HALF * BK * 2, STAGE_BYTES = 8 * HTB, NXCD = 8, WGM = 8;
__host__ __device__ __forceinline__ int lds_byte(int r, int c) { const int st = (r >> 4) * 2 + (c >> 5), rr = r & 15, cc = c & 31, ob = rr * 64 + cc * 2; return st * 1024 + (ob ^ (((ob >> 9) & 1) << 5)); }
__host__ __device__ __forceinline__ void stage_rc(int b, int& R, int& C) { const int st = b / 1024, sb = b % 1024, swz = sb ^ (((sb >> 9) & 1) << 5); R = (st >> 1) * 16 + swz / 64; C = (st & 1) * 32 + (swz % 64) / 2; }
__host__ __device__ __forceinline__ int perm32(int rho) { const int n = rho >> 4, i = rho & 15; return 8 * (i >> 2) + 4 * n + (i & 3); }

struct Unit { int pm, pn; };
struct Gemm { const bf16_t* A; const bf16_t* Bt; int lda, ldb, K, a_pn_off, nM, nN, pm0; };

struct Order {
    int nM, nN, nwg, G, c, pm0;
    __device__ __forceinline__ void init(int nM_, int nN_, int G_, int c_, int pm0_) { nM = nM_; nN = nN_; nwg = nM * nN; G = G_; c = c_; pm0 = pm0_; }
    __device__ __forceinline__ bool next(int i, Unit& u) const {
        const long L = (long)i * G + c; if (L >= nwg) return false;
        int wgid = (int)L; { const int q = nwg / NXCD, r = nwg % NXCD, xcd = wgid % NXCD, off = wgid / NXCD; wgid = (xcd < r ? xcd * (q + 1) : r * (q + 1) + (xcd - r) * q) + off; }
        const int nig = WGM * nN, gid = wgid / nig, fm = gid * WGM, gsz = (nM - fm) < WGM ? (nM - fm) : WGM;
        u.pm = fm + ((wgid % nig) % gsz) + pm0; u.pn = (wgid % nig) / gsz; return true;
    }
};

template <class Epi>
__device__ __forceinline__ void gemm_phase(LAS unsigned char* lds, const Gemm g, const int G, const int cblk, const Epi& E) {
    int tid_ = threadIdx.x; asm volatile("" : "+v"(tid_));
    const int tid = tid_, wid = __builtin_amdgcn_readfirstlane(tid >> 6), lane = tid & 63, wr = wid >> 2, wc = wid & 3, fr = lane & 15, fq = lane >> 4;
    const int nt = g.K / BK;
    Order S; S.init(g.nM, g.nN, G, cblk, g.pm0);
    unsigned voffA[2], voffB[2];
#pragma unroll
    for (int i = 0; i < 2; ++i) { int R, C; stage_rc(tid * 16 + i * 8192, R, C); const int Rb = (R & ~31) + perm32(R & 31);
        voffA[i] = (unsigned)(R * g.lda + C) * 2u; voffB[i] = (unsigned)(Rb * g.ldb + C) * 2u; }
    const size_t kstep = (size_t)(BK * 2);
    const size_t hstepA = (size_t)HALF * g.lda * 2, hstepB = (size_t)HALF * g.ldb * 2;
    const unsigned ldsw = (unsigned)wid * 1024u;
    const int aoff = lds_byte(wr * 64 + fr, fq * 8), boff = lds_byte(wc * 32 + fr, fq * 8);
#define PG8_UA(u) ((const char*)g.A + ((size_t)(u).pm * BM * g.lda + (size_t)(u).pn * g.a_pn_off) * 2)
#define PG8_UB(u) ((const char*)g.Bt + (size_t)(u).pn * BM * g.ldb * 2)
#define PG8_SA(b, h) (((b) * 2 + (h)) * HTB)
#define PG8_SB(b, h) ((4 + (b) * 2 + (h)) * HTB)
#define PG8_STAGE(bufoff, gbase, voff) do { _Pragma("unroll") for (int _i = 0; _i < 2; ++_i) \
        __builtin_amdgcn_global_load_lds((const unsigned*)((const char*)(gbase) + (voff)[_i]), (LAS unsigned*)(lds + (bufoff) + ldsw + _i * 8192), 16, 0, 0); } while (0)
#define PG8_LDA(dst, b, h) do { _Pragma("unroll") for (int m = 0; m < 4; ++m) _Pragma("unroll") for (int k = 0; k < 2; ++k) dst[m][k] = *(const LAS bf16x8*)(lds + PG8_SA(b, h) + aoff + m * 2048 + k * 1024); } while (0)
#define PG8_LDB(dst, b, h) do { _Pragma("unroll") for (int n = 0; n < 2; ++n) _Pragma("unroll") for (int k = 0; k < 2; ++k) dst[n][k] = *(const LAS bf16x8*)(lds + PG8_SB(b, h) + boff + n * 2048 + k * 1024); } while (0)
#define PG8_MMA(ai, bj, At, Bt) do { __builtin_amdgcn_s_setprio(1); _Pragma("unroll") for (int m = 0; m < 4; ++m) _Pragma("unroll") for (int n = 0; n < 2; ++n) _Pragma("unroll") for (int k = 0; k < 2; ++k) \
        acc[ai][bj][m][n] = __builtin_amdgcn_mfma_f32_16x16x32_bf16(Bt[n][k], At[m][k], acc[ai][bj][m][n], 0, 0, 0); __builtin_amdgcn_s_setprio(0); } while (0)
#define PG8_WAIT_V(n) asm volatile("s_waitcnt vmcnt(" #n ")" ::: "memory")
#define PG8_WAIT_L(n) asm volatile("s_waitcnt lgkmcnt(" #n ")" ::: "memory")
#define PG8_BAR __builtin_amdgcn_s_barrier()
#define PG8_SCHED __builtin_amdgcn_sched_barrier(0)
    Unit cur, nxt; int ui = 0;
    if (!S.next(0, cur)) return;
    f32x4 acc[2][2][4][2];
#pragma unroll
    for (int a = 0; a < 2; ++a)
#pragma unroll
        for (int b = 0; b < 2; ++b)
#pragma unroll
            for (int m = 0; m < 4; ++m)
#pragma unroll
                for (int n = 0; n < 2; ++n) acc[a][b][m][n] = (f32x4){0.f, 0.f, 0.f, 0.f};
    bf16x8 At[4][2], B0[2][2], B1[2][2];
    const char* cA = PG8_UA(cur); const char* cB = PG8_UB(cur);
    PG8_STAGE(PG8_SB(0, 0), cB, voffB); PG8_STAGE(PG8_SB(0, 1), cB + hstepB, voffB); PG8_STAGE(PG8_SA(0, 0), cA, voffA); PG8_STAGE(PG8_SA(0, 1), cA + hstepA, voffA);
    if (wr == 1) PG8_BAR;
    PG8_WAIT_V(2); PG8_BAR;
    PG8_STAGE(PG8_SB(1, 0), cB + kstep, voffB); PG8_STAGE(PG8_SA(1, 0), cA + kstep, voffA); PG8_STAGE(PG8_SB(1, 1), cB + hstepB + kstep, voffB);
    PG8_WAIT_V(6); PG8_BAR;
    for (;;) {
        const bool has_next = S.next(ui + 1, nxt);
        const char* nA = has_next ? PG8_UA(nxt) : cA; const char* nB = has_next ? PG8_UB(nxt) : cB;
        for (int t = 0; t < nt; t += 2) {
            const bool last = (t == nt - 2);
            const char* a1 = cA + (size_t)(t + 1) * kstep;
            const char* a2 = last ? nA : cA + (size_t)(t + 2) * kstep; const char* b2 = last ? nB : cB + (size_t)(t + 2) * kstep;
            const char* a3 = a2 + kstep; const char* b3 = b2 + kstep;
            PG8_LDB(B0, 0, 0); PG8_LDB(B1, 0, 1); PG8_SCHED; PG8_LDA(At, 0, 0); PG8_STAGE(PG8_SA(1, 1), a1 + hstepA, voffA);
            PG8_WAIT_V(8); PG8_WAIT_L(0); PG8_BAR; PG8_MMA(0, 0, At, B0); PG8_MMA(0, 1, At, B1); PG8_BAR; PG8_SCHED;
            PG8_LDA(At, 0, 1); PG8_STAGE(PG8_SB(0, 0), b2, voffB); PG8_STAGE(PG8_SB(0, 1), b2 + hstepB, voffB); PG8_STAGE(PG8_SA(0, 0), a2, voffA);
            PG8_WAIT_V(8); PG8_WAIT_L(0); PG8_BAR; PG8_MMA(1, 0, At, B0); PG8_MMA(1, 1, At, B1); PG8_BAR; PG8_SCHED;
            PG8_LDB(B0, 1, 0); PG8_LDB(B1, 1, 1); PG8_SCHED; PG8_LDA(At, 1, 0); PG8_STAGE(PG8_SA(0, 1), a2 + hstepA, voffA);
            PG8_WAIT_V(8); PG8_WAIT_L(0); PG8_BAR; PG8_MMA(0, 0, At, B0); PG8_MMA(0, 1, At, B1); PG8_BAR; PG8_SCHED;
            PG8_LDA(At, 1, 1); PG8_STAGE(PG8_SB(1, 0), b3, voffB); PG8_STAGE(PG8_SB(1, 1), b3 + hstepB, voffB); PG8_STAGE(PG8_SA(1, 0), a3, voffA);
            PG8_WAIT_V(8); PG8_WAIT_L(0); PG8_BAR; PG8_MMA(1, 0, At, B0); PG8_MMA(1, 1, At, B1); PG8_BAR; PG8_SCHED;
        }
        if (wr == 0) PG8_BAR;
        E(acc, cur, wr, wc, fr, fq);
        if (!has_next) break;
#pragma unroll
        for (int a = 0; a < 2; ++a)
#pragma unroll
            for (int b = 0; b < 2; ++b)
#pragma unroll
                for (int m = 0; m < 4; ++m)
#pragma unroll
                    for (int n = 0; n < 2; ++n) acc[a][b][m][n] = (f32x4){0.f, 0.f, 0.f, 0.f};
        cur = nxt; cA = nA; cB = nB; ++ui;
        if (wr == 1) PG8_BAR;
    }
    PG8_WAIT_V(0);
    PG8_BAR;
#undef PG8_UA
#undef PG8_UB
#undef PG8_SA
#undef PG8_SB
#undef PG8_STAGE
#undef PG8_LDA
#undef PG8_LDB
#undef PG8_MMA
#undef PG8_WAIT_V
#undef PG8_WAIT_L
#undef PG8_BAR
#undef PG8_SCHED
}

struct EpiResid {
    const float* base_lo; const float* base_hi; int split_row;
    float* xf; bf16_t* xb; float* ssp; const float* cscale;
    __device__ __forceinline__ void operator()(const f32x4 (&acc)[2][2][4][2], const Unit& u, int wr, int wc, int fr, int fq) const {
        const int row0 = u.pm * BM + wr * 64 + fr, col0 = u.pn * BM + wc * 32 + 8 * fq;
        f32x4 cs[2][2];
#pragma unroll
        for (int bj = 0; bj < 2; ++bj)
#pragma unroll
            for (int n = 0; n < 2; ++n) cs[bj][n] = cscale ? *(const f32x4*)(cscale + col0 + bj * HALF + 4 * n) : (f32x4){1.f, 1.f, 1.f, 1.f};
        const float* bp = (u.pm * BM < split_row) ? base_lo : (base_hi - (size_t)split_row * D);
#pragma unroll
        for (int ai = 0; ai < 2; ++ai)
#pragma unroll
            for (int m = 0; m < 4; ++m) {
                const int row = row0 + ai * HALF + m * 16; const size_t off = (size_t)row * D + col0; float ss = 0.f;
#pragma unroll
                for (int bj = 0; bj < 2; ++bj) {
                    const f32x4 b0 = *(const f32x4*)(bp + off + bj * HALF), b1 = *(const f32x4*)(bp + off + bj * HALF + 4);
                    const f32x4 v0 = b0 + acc[ai][bj][m][0] * cs[bj][0], v1 = b1 + acc[ai][bj][m][1] * cs[bj][1];
                    ss += (v0[0] * v0[0] + v0[1] * v0[1]) + (v0[2] * v0[2] + v0[3] * v0[3]) + (v1[0] * v1[0] + v1[1] * v1[1]) + (v1[2] * v1[2] + v1[3] * v1[3]);
                    *(f32x4*)(xf + off + bj * HALF) = v0; *(f32x4*)(xf + off + bj * HALF + 4) = v1;
                    u32x4 w; w.x = pk_bf16(v0[0], v0[1]); w.y = pk_bf16(v0[2], v0[3]); w.z = pk_bf16(v1[0], v1[1]); w.w = pk_bf16(v1[2], v1[3]);
                    *(u32x4*)(xb + off + bj * HALF) = w;
                }
                ss += __shfl_xor(ss, 16); ss += __shfl_xor(ss, 32);
                if (fq == 0) ssp[(size_t)row * 16 + u.pn * 4 + wc] = ss;
            }
    }
};
struct EpiRowScale {
    bf16_t* out; int ldc; const float* ssp; float cst; int tsplit; bf16_t* vt; int t_pm_stride, t_ld;
    __device__ __forceinline__ void operator()(const f32x4 (&acc)[2][2][4][2], const Unit& u, int wr, int wc, int fr, int fq) const {
        const int rl0 = wr * 64 + fr, col0 = u.pn * BM + wc * 32 + 8 * fq;
        const bool tr = u.pn >= tsplit;
#pragma unroll
        for (int ai = 0; ai < 2; ++ai)
#pragma unroll
            for (int m = 0; m < 4; ++m) {
                const int rl = rl0 + ai * HALF + m * 16, row = u.pm * BM + rl;
                const float rs = rstd_from(ssp + (size_t)row * 16) * cst;
#pragma unroll
                for (int bj = 0; bj < 2; ++bj) {
                    const f32x4 v0 = acc[ai][bj][m][0] * rs, v1 = acc[ai][bj][m][1] * rs;
                    u32x4 w; w.x = pk_bf16(v0[0], v0[1]); w.y = pk_bf16(v0[2], v0[3]); w.z = pk_bf16(v1[0], v1[1]); w.w = pk_bf16(v1[2], v1[3]);
                    if (!tr) *(u32x4*)(out + (size_t)row * ldc + col0 + bj * HALF) = w;
                    else { bf16_t* p = vt + (size_t)u.pm * t_pm_stride + (size_t)(col0 - tsplit * BM + bj * HALF) * t_ld + rl;
                        p[0] = (bf16_t)w.x; p[(size_t)t_ld] = (bf16_t)(w.x >> 16); p[(size_t)2 * t_ld] = (bf16_t)w.y; p[(size_t)3 * t_ld] = (bf16_t)(w.y >> 16);
                        p[(size_t)4 * t_ld] = (bf16_t)w.z; p[(size_t)5 * t_ld] = (bf16_t)(w.z >> 16); p[(size_t)6 * t_ld] = (bf16_t)w.w; p[(size_t)7 * t_ld] = (bf16_t)(w.w >> 16); }
                }
            }
    }
};
struct EpiUp {
    bf16_t* out; const float* ssp;
    __device__ __forceinline__ void operator()(const f32x4 (&acc)[2][2][4][2], const Unit& u, int wr, int wc, int fr, int fq) const {
        const int row0 = u.pm * BM + wr * 64 + fr, col0 = u.pn * BM + wc * 32 + 8 * fq;
#pragma unroll
        for (int ai = 0; ai < 2; ++ai)
#pragma unroll
            for (int m = 0; m < 4; ++m) {
                const int row = row0 + ai * HALF + m * 16;
                const float rs = rstd_from(ssp + (size_t)row * 16);
#pragma unroll
                for (int bj = 0; bj < 2; ++bj) {
                    f32x4 v0 = acc[ai][bj][m][0] * rs, v1 = acc[ai][bj][m][1] * rs;
#pragma unroll
                    for (int e = 0; e < 4; ++e) { v0[e] = fmaxf(v0[e], 0.f); v0[e] *= v0[e]; v1[e] = fmaxf(v1[e], 0.f); v1[e] *= v1[e]; }
                    u32x4 w; w.x = pk_bf16(v0[0], v0[1]); w.y = pk_bf16(v0[2], v0[3]); w.z = pk_bf16(v1[0], v1[1]); w.w = pk_bf16(v1[2], v1[3]);
                    *(u32x4*)(out + (size_t)row * FF + col0 + bj * HALF) = w;
                }
            }
    }
};
struct EpiQKV {
    bf16_t* qb; bf16_t* kw; bf16_t* vt; const float* ssp; const float* ropec; const float* ropes;
    __device__ __forceinline__ void operator()(const f32x4 (&acc)[2][2][4][2], const Unit& u, int wr, int wc, int fr, int fq) const {
        const int row0 = u.pm * BM + wr * 64 + fr, colt = wc * 32 + 8 * fq;
        const int dd = 16 * (wc & 1) + 4 * fq;
#pragma unroll
        for (int ai = 0; ai < 2; ++ai)
#pragma unroll
            for (int m = 0; m < 4; ++m) {
                const int row = row0 + ai * HALF + m * 16;
                const float rs = rstd_from(ssp + (size_t)row * 16);
                if (u.pn < 5) {
                    const int pos = row < TP ? (row & (SEQP - 1)) : (row & (SEQS - 1));
                    const f32x4 c = *(const f32x4*)(ropec + pos * 32 + dd), s = *(const f32x4*)(ropes + pos * 32 + dd);
                    const float sc = rs * (u.pn < 4 ? 0.125f * LOG2E : 1.0f);
#pragma unroll
                    for (int bj = 0; bj < 2; ++bj) {
                        const f32x4 x1 = acc[ai][bj][m][0] * sc, x2 = acc[ai][bj][m][1] * sc;
                        const f32x4 o1 = x1 * c - x2 * s, o2 = x2 * c + x1 * s;
                        u32x4 w; w.x = pk_bf16(o1[0], o1[1]); w.y = pk_bf16(o1[2], o1[3]); w.z = pk_bf16(o2[0], o2[1]); w.w = pk_bf16(o2[2], o2[3]);
                        if (u.pn < 4) *(u32x4*)(qb + (size_t)row * D + u.pn * BM + colt + bj * HALF) = w;
                        else *(u32x4*)(kw + (size_t)row * 256 + colt + bj * HALF) = w;
                    }
                } else {
#pragma unroll
                    for (int bj = 0; bj < 2; ++bj) {
                        const f32x4 v0 = acc[ai][bj][m][0] * rs, v1 = acc[ai][bj][m][1] * rs;
                        u32x4 w; w.x = pk_bf16(v0[0], v0[1]); w.y = pk_bf16(v0[2], v0[3]); w.z = pk_bf16(v1[0], v1[1]); w.w = pk_bf16(v1[2], v1[3]);
                        bf16_t* p = vt + (size_t)(colt + bj * HALF) * T + row;
                        p[0] = (bf16_t)w.x; p[(size_t)T] = (bf16_t)(w.x >> 16); p[(size_t)2 * T] = (bf16_t)w.y; p[(size_t)3 * T] = (bf16_t)(w.y >> 16);
                        p[(size_t)4 * T] = (bf16_t)w.z; p[(size_t)5 * T] = (bf16_t)(w.z >> 16); p[(size_t)6 * T] = (bf16_t)w.w; p[(size_t)7 * T] = (bf16_t)(w.w >> 16);
                    }
                }
            }
    }
};
}

#define MFMA32(a, b, c) __builtin_amdgcn_mfma_f32_32x32x16_bf16((a), (b), (c), 0, 0, 0)
__device__ __forceinline__ int swap23(int r) { return (r & 0x13) | ((r & 4) << 1) | ((r & 8) >> 1); }
__device__ __forceinline__ bf16x8 pack8(const f32x16& x, int s) {
    u32x4 p; p.x = pk_bf16(x[8 * s + 0], x[8 * s + 1]); p.y = pk_bf16(x[8 * s + 2], x[8 * s + 3]); p.z = pk_bf16(x[8 * s + 4], x[8 * s + 5]); p.w = pk_bf16(x[8 * s + 6], x[8 * s + 7]);
    return __builtin_bit_cast(bf16x8, p);
}
__device__ __forceinline__ float vmax16(const f32x16& x) {
    float a = fmaxf(fmaxf(x[0], x[1]), fmaxf(x[2], x[3])), b = fmaxf(fmaxf(x[4], x[5]), fmaxf(x[6], x[7]));
    float c = fmaxf(fmaxf(x[8], x[9]), fmaxf(x[10], x[11])), d = fmaxf(fmaxf(x[12], x[13]), fmaxf(x[14], x[15]));
    return fmaxf(fmaxf(a, b), fmaxf(c, d));
}

constexpr int XA_KP = 144, XA_VP = 528, XA_BUF = 256 * XA_KP;
__device__ __forceinline__ void xattn_unit(LAS unsigned char* lds, bf16_t* QO, const bf16_t* KM, const bf16_t* VMT, int qt, int h) {
    int tid_ = threadIdx.x; asm volatile("" : "+v"(tid_));
    const int tid = tid_, lane = tid & 63, wid = __builtin_amdgcn_readfirstlane(tid >> 6), r32 = lane & 31, hi = lane >> 5;
    const int seq = qt < 128 ? (qt >> 3) : 16 + ((qt - 128) >> 5);
    const bf16_t* Kg = KM + (size_t)(seq * 256) * D + h * 256;
    const bf16_t* Vg = VMT + ((size_t)seq * D + h * 256) * 256;
    bf16_t* Qg = QO + (size_t)(qt * 256 + wid * 32 + r32) * D + h * 256;
    u32x4 st[4];
#define XA_LOADK(c) do { _Pragma("unroll") for (int i = 0; i < 4; ++i) { const int ch = tid + 512 * i, row = ch >> 3, c16 = ch & 7; st[i] = *(const u32x4*)(Kg + (size_t)row * D + (c) * 64 + c16 * 8); } } while (0)
#define XA_LOADV(c) do { _Pragma("unroll") for (int i = 0; i < 4; ++i) { const int ch = tid + 512 * i, row = ch >> 5, c16 = ch & 31; st[i] = *(const u32x4*)(Vg + (size_t)((c) * 64 + row) * 256 + c16 * 8); } } while (0)
#define XA_WRK(buf) do { _Pragma("unroll") for (int i = 0; i < 4; ++i) { const int ch = tid + 512 * i, row = ch >> 3, c16 = ch & 7; *(LAS u32x4*)(lds + (buf) * XA_BUF + row * XA_KP + c16 * 16) = st[i]; } } while (0)
#define XA_WRV(buf) do { _Pragma("unroll") for (int i = 0; i < 4; ++i) { const int ch = tid + 512 * i, row = ch >> 5, c16 = ch & 31; *(LAS u32x4*)(lds + (buf) * XA_BUF + row * XA_VP + c16 * 16) = st[i]; } } while (0)
    XA_LOADK(0); XA_WRK(0); __syncthreads();
    f32x16 sc[8];
#pragma unroll
    for (int kb = 0; kb < 8; ++kb)
#pragma unroll
        for (int r = 0; r < 16; ++r) sc[kb][r] = 0.f;
    const int koff = swap23(r32) * XA_KP + hi * 16;
#pragma unroll 1
    for (int c = 0; c < 4; ++c) {
        if (c < 3) XA_LOADK(c + 1); else XA_LOADV(0);
        bf16x8 qf[4];
#pragma unroll
        for (int ds = 0; ds < 4; ++ds) qf[ds] = *(const bf16x8*)(Qg + c * 64 + ds * 16 + hi * 8);
        const LAS unsigned char* kb_base = lds + (c & 1) * XA_BUF + koff;
#pragma unroll
        for (int kb = 0; kb < 8; ++kb)
#pragma unroll
            for (int ds = 0; ds < 4; ++ds) { const bf16x8 kf = *(const LAS bf16x8*)(kb_base + kb * 32 * XA_KP + ds * 32); sc[kb] = MFMA32(kf, qf[ds], sc[kb]); if (ds == 3 && (kb & 1)) __builtin_amdgcn_sched_barrier(0); }
        if (c < 3) XA_WRK((c + 1) & 1); else XA_WRV(0);
        __syncthreads();
    }
    float mx = vmax16(sc[0]);
#pragma unroll
    for (int kb = 1; kb < 8; ++kb) mx = fmaxf(mx, vmax16(sc[kb]));
    mx = fmaxf(mx, __shfl_xor(mx, 32));
    float l = 0.f;
#pragma unroll
    for (int kb = 0; kb < 8; ++kb)
#pragma unroll
        for (int r = 0; r < 16; ++r) { const float p = __builtin_amdgcn_exp2f(sc[kb][r] - mx); sc[kb][r] = p; l += p; }
    l += __shfl_xor(l, 32);
    const float inv = 1.0f / l;
    bf16x8 pf[16];
#pragma unroll
    for (int kb = 0; kb < 8; ++kb) { pf[2 * kb] = pack8(sc[kb], 0); pf[2 * kb + 1] = pack8(sc[kb], 1); }
    const int voff = r32 * XA_VP + hi * 16;
#pragma unroll 1
    for (int c = 0; c < 4; ++c) {
        if (c < 3) XA_LOADV(c + 1);
        f32x16 o[2];
#pragma unroll
        for (int db = 0; db < 2; ++db)
#pragma unroll
            for (int r = 0; r < 16; ++r) o[db][r] = 0.f;
        const LAS unsigned char* vb_base = lds + (c & 1) * XA_BUF + voff;
#pragma unroll
        for (int ks = 0; ks < 16; ++ks)
#pragma unroll
            for (int db = 0; db < 2; ++db) { const bf16x8 vf = *(const LAS bf16x8*)(vb_base + db * 32 * XA_VP + ks * 32); o[db] = MFMA32(vf, pf[ks], o[db]); if (db == 1 && (ks & 3) == 3) __builtin_amdgcn_sched_barrier(0); }
#pragma unroll
        for (int db = 0; db < 2; ++db)
#pragma unroll
            for (int gq = 0; gq < 4; ++gq) {
                u32x2 w; w.x = pk_bf16(o[db][4 * gq] * inv, o[db][4 * gq + 1] * inv); w.y = pk_bf16(o[db][4 * gq + 2] * inv, o[db][4 * gq + 3] * inv);
                *(u32x2*)(Qg + c * 64 + db * 32 + gq * 8 + hi * 4) = w;
            }
        if (c < 3) XA_WRV((c + 1) & 1);
        __syncthreads();
    }
#undef XA_LOADK
#undef XA_LOADV
#undef XA_WRK
#undef XA_WRV
}

constexpr int WA_P = 144, WA_TB = 64 * WA_P;
__device__ __forceinline__ void wattn_unit(LAS unsigned char* lds, bf16_t* QO, const bf16_t* KW, const bf16_t* VT, const float* sinks, int qt, int hq) {
    int tid_ = threadIdx.x; asm volatile("" : "+v"(tid_));
    const int tid = tid_, lane = tid & 63, wid = __builtin_amdgcn_readfirstlane(tid >> 6), r32 = lane & 31, hi = lane >> 5;
    const int S = qt < 128 ? SEQP : SEQS;
    const int seq_row0 = qt < 128 ? (qt >> 3) * SEQP : TP + ((qt - 128) >> 5) * SEQS;
    const int q0 = qt * 256, q0s = q0 - seq_row0, kvh = hq >> 2;
    const int t_lo = (q0s == 0) ? 2 : 0, t_hi = (q0s + 256 == S) ? 5 : 7;
    const int tw_lo = wid >> 1, tw_hi = (wid >> 1) + 4;
    bf16_t* Qg = QO + (size_t)(q0 + wid * 32 + r32) * D + hq * 64;
    const int srow = tid >> 3, sc16 = tid & 7;
    const bf16_t* Kg = KW + (size_t)(q0 - 128 + srow) * 256 + kvh * 64 + sc16 * 8;
    const bf16_t* Vg = VT + (size_t)(kvh * 64 + srow) * T + (q0 - 128) + sc16 * 8;
    const int soff = srow * WA_P + sc16 * 16;
    u32x4 stk, stv;
    stk = *(const u32x4*)(Kg + (size_t)t_lo * 64 * 256); stv = *(const u32x4*)(Vg + t_lo * 64);
    bf16x8 qf[4];
#pragma unroll
    for (int ds = 0; ds < 4; ++ds) qf[ds] = *(const bf16x8*)(Qg + ds * 16 + hi * 8);
    *(LAS u32x4*)(lds + (t_lo & 1) * WA_TB + soff) = stk; *(LAS u32x4*)(lds + (2 + (t_lo & 1)) * WA_TB + soff) = stv;
    __syncthreads();
    float mrun = -1e30f, l = 0.f;
    f32x16 o[2];
#pragma unroll
    for (int db = 0; db < 2; ++db)
#pragma unroll
        for (int r = 0; r < 16; ++r) o[db][r] = 0.f;
    const int koff = swap23(r32) * WA_P + hi * 16, voff = r32 * WA_P + hi * 16;
    const int qrel = wid * 32 + r32;
#pragma unroll 1
    for (int t = t_lo; t <= t_hi; ++t) {
        if (t < t_hi) { stk = *(const u32x4*)(Kg + (size_t)(t + 1) * 64 * 256); stv = *(const u32x4*)(Vg + (t + 1) * 64); }
        if (t >= tw_lo && t <= tw_hi) {
            const LAS unsigned char* kb_base = lds + (t & 1) * WA_TB + koff;
            const LAS unsigned char* vb_base = lds + (2 + (t & 1)) * WA_TB + voff;
            f32x16 s[2];
#pragma unroll
            for (int kb = 0; kb < 2; ++kb) {
#pragma unroll
                for (int r = 0; r < 16; ++r) s[kb][r] = 0.f;
#pragma unroll
                for (int ds = 0; ds < 4; ++ds) { const bf16x8 kf = *(const LAS bf16x8*)(kb_base + kb * 32 * WA_P + ds * 32); s[kb] = MFMA32(kf, qf[ds], s[kb]); }
            }
            const bool full = (64 * t >= wid * 32 + 31) && (64 * t + 63 <= wid * 32 + 256);
            if (!full) {
                const int kap0 = 64 * t + 8 * hi - qrel;
#pragma unroll
                for (int kb = 0; kb < 2; ++kb)
#pragma unroll
                    for (int r = 0; r < 16; ++r) { const int dlt = kap0 + 32 * kb + 16 * (r >> 3) + (r & 7); if (dlt < 0 || dlt > 256) s[kb][r] = -1e30f; }
            }
            float mx = fmaxf(vmax16(s[0]), vmax16(s[1]));
            mx = fmaxf(mx, __shfl_xor(mx, 32));
            const float mnew = fmaxf(mrun, mx), alpha = __builtin_amdgcn_exp2f(mrun - mnew);
            mrun = mnew;
            float ls = 0.f;
#pragma unroll
            for (int kb = 0; kb < 2; ++kb)
#pragma unroll
                for (int r = 0; r < 16; ++r) { const float p = __builtin_amdgcn_exp2f(s[kb][r] - mnew); s[kb][r] = p; ls += p; }
            l = l * alpha + ls;
#pragma unroll
            for (int db = 0; db < 2; ++db)
#pragma unroll
                for (int r = 0; r < 16; ++r) o[db][r] *= alpha;
            bf16x8 pf[4];
            pf[0] = pack8(s[0], 0); pf[1] = pack8(s[0], 1); pf[2] = pack8(s[1], 0); pf[3] = pack8(s[1], 1);
#pragma unroll
            for (int ks = 0; ks < 4; ++ks)
#pragma unroll
                for (int db = 0; db < 2; ++db) { const bf16x8 vf = *(const LAS bf16x8*)(vb_base + db * 32 * WA_P + ks * 32); o[db] = MFMA32(vf, pf[ks], o[db]); }
        }
        if (t < t_hi) { *(LAS u32x4*)(lds + ((t + 1) & 1) * WA_TB + soff) = stk; *(LAS u32x4*)(lds + (2 + ((t + 1) & 1)) * WA_TB + soff) = stv; }
        __syncthreads();
    }
    l += __shfl_xor(l, 32);
    l += __builtin_amdgcn_exp2f(sinks[hq] * LOG2E - mrun);
    const float inv = 1.0f / l;
#pragma unroll
    for (int db = 0; db < 2; ++db)
#pragma unroll
        for (int gq = 0; gq < 4; ++gq) {
            u32x2 w; w.x = pk_bf16(o[db][4 * gq] * inv, o[db][4 * gq + 1] * inv); w.y = pk_bf16(o[db][4 * gq + 2] * inv, o[db][4 * gq + 3] * inv);
            *(u32x2*)(Qg + db * 32 + gq * 8 + hi * 4) = w;
        }
}

__device__ __forceinline__ unsigned f2bf(float f) { return pk_bf16(f, 0.f) & 0xffffu; }
__device__ __forceinline__ void p0_transpose_item(const float* W, int K, int N, bf16_t* WT, const float* gain, int permlim, LAS float* scr, int item, int lane) {
    const int nblk = N / 32, kb = item / nblk, nb = item % nblk, k0 = 64 * kb, n0 = 32 * nb;
#pragma unroll 8
    for (int i = 0; i < 32; ++i) { const int kk = 2 * i + (lane >> 5); const float gv = gain ? gain[k0 + kk] : 1.0f; scr[kk * 33 + (lane & 31)] = W[(size_t)(k0 + kk) * N + n0 + (lane & 31)] * gv; }
    asm volatile("s_waitcnt lgkmcnt(0)" ::: "memory");
    const int c = lane & 7;
#pragma unroll
    for (int j = 0; j < 4; ++j) { const int n = (lane >> 3) + 8 * j; const LAS float* s = scr + (8 * c) * 33 + n;
        u32x4 o; o.x = pk_bf16(s[0 * 33], s[1 * 33]); o.y = pk_bf16(s[2 * 33], s[3 * 33]); o.z = pk_bf16(s[4 * 33], s[5 * 33]); o.w = pk_bf16(s[6 * 33], s[7 * 33]);
        int nn = n0 + n;
        if (nn < permlim) { const int d = nn & 63; const int p = (d < 32) ? (8 * (d >> 2) + (d & 3)) : (8 * ((d - 32) >> 2) + 4 + (d & 3)); nn = (nn & ~63) | p; }
        *(u32x4*)(WT + (size_t)nn * K + k0 + 8 * c) = o; }
    asm volatile("s_waitcnt lgkmcnt(0)" ::: "memory");
}

struct Args { const float* in[19]; float* out; unsigned char* ws; int lo, hi; };

__device__ __forceinline__ void prologue_phase(const Args& a, LAS unsigned char* lds, int vcu, int G) {
    int tid_ = threadIdx.x; asm volatile("" : "+v"(tid_));
    const int tid = tid_, lane = tid & 63, wave = __builtin_amdgcn_readfirstlane(tid >> 6);
    unsigned char* ws = a.ws;
    LAS float* scr = (LAS float*)(lds + wave * 16384);
    const int gw = vcu * NWAVES + wave, NGW = G * NWAVES;
    constexpr int I_PW = 4 * 8, I_QKV = 16 * 48, I_DD = 16 * 32, I_KV = 16 * 64, I_UP = 16 * 128, I_DN = 64 * 32;
    constexpr int NITEMS = 4 * I_PW + I_QKV + I_DD + 2 * I_DD + 2 * I_KV + 2 * I_DD + 2 * I_UP + 2 * I_DN;
    for (int it = gw; it < NITEMS; it += NGW) {
        int r = it;
        if (r < 4 * I_PW) { const int gI = r / I_PW; p0_transpose_item(a.in[5] + (size_t)gI * 65536, 256, 256, (bf16_t*)(ws + WS_PW) + (size_t)gI * 65536, nullptr, 0, scr, r % I_PW, lane); continue; } r -= 4 * I_PW;
        if (r < I_QKV) { p0_transpose_item(a.in[7], D, NQKV, (bf16_t*)(ws + WS_WQKV), a.in[4] + D, 1280, scr, r, lane); continue; } r -= I_QKV;
        if (r < I_DD) { p0_transpose_item(a.in[8], D, D, (bf16_t*)(ws + WS_WAO), nullptr, 0, scr, r, lane); continue; } r -= I_DD;
        if (r < 2 * I_DD) { const int L = r / I_DD; p0_transpose_item(a.in[12] + (size_t)L * D * D, D, D, (bf16_t*)(ws + WS_WXQ) + (size_t)L * D * D, a.in[10] + L * D, 0, scr, r % I_DD, lane); continue; } r -= 2 * I_DD;
        if (r < 2 * I_KV) { const int L = r / I_KV; p0_transpose_item(a.in[13] + (size_t)L * D * 2 * D, D, 2 * D, (bf16_t*)(ws + WS_WXKV) + (size_t)L * D * 2 * D, a.in[11] + L * D, 0, scr, r % I_KV, lane); continue; } r -= 2 * I_KV;
        if (r < 2 * I_DD) { const int L = r / I_DD; p0_transpose_item(a.in[14] + (size_t)L * D * D, D, D, (bf16_t*)(ws + WS_WXO) + (size_t)L * D * D, nullptr, 0, scr, r % I_DD, lane); continue; } r -= 2 * I_DD;
        if (r < 2 * I_UP) { const int L = r / I_UP; p0_transpose_item(a.in[16] + (size_t)L * D * FF, D, FF, (bf16_t*)(ws + WS_WUP) + (size_t)L * D * FF, a.in[15] + L * D, 0, scr, r % I_UP, lane); continue; } r -= 2 * I_UP;
        { const int L = r / I_DN; p0_transpose_item(a.in[17] + (size_t)L * D * FF, FF, D, (bf16_t*)(ws + WS_WDN) + (size_t)L * D * FF, nullptr, 0, scr, r % I_DN, lane); }
    }
    { float* rc = (float*)(ws + WS_ROPE); float* rsn = rc + SEQS * 32;
      for (int idx = (vcu * NTHR + tid); idx < SEQS * 32; idx += G * NTHR) {
          const int pos = idx >> 5, i = idx & 31;
          const float invf = exp2f(-(float)(2 * i) * (13.287712379549449f / 64.0f));
          const float ang = (float)pos * invf;
          const double rev = (double)ang * 0.15915494309189535; const float fr = (float)(rev - floor(rev));
          rc[idx] = __builtin_amdgcn_cosf(fr); rsn[idx] = __builtin_amdgcn_sinf(fr); } }
    for (int m = gw; m < NMEMROWS; m += NGW) {
        const float* src = (m < 4096) ? a.in[2] + (size_t)m * D : a.in[3] + (size_t)(m - 4096) * D;
        f32x4 v[4]; float s = 0.f;
#pragma unroll
        for (int j = 0; j < 4; ++j) { v[j] = *((const f32x4*)src + lane + 64 * j); s += (v[j][0] * v[j][0] + v[j][1] * v[j][1]) + (v[j][2] * v[j][2] + v[j][3] * v[j][3]); }
        s = wave_sum(s);
        u32x2* o8 = (u32x2*)((bf16_t*)(ws + WS_MB) + (size_t)m * D) + lane;
#pragma unroll
        for (int j = 0; j < 4; ++j) { u32x2 w; w.x = pk_bf16(v[j][0], v[j][1]); w.y = pk_bf16(v[j][2], v[j][3]); o8[64 * j] = w; }
        if (lane < 16) ((float*)(ws + WS_SSPM))[(size_t)m * 16 + lane] = (lane == 0) ? s : 0.f;
    }
    for (int m = gw; m < T; m += NGW) {
        const float* src = (m < TP) ? a.in[0] + (size_t)m * D : a.in[1] + (size_t)(m - TP) * D;
        float s = 0.f;
#pragma unroll
        for (int j = 0; j < 4; ++j) { const f32x4 v = *((const f32x4*)src + lane + 64 * j); s += (v[0] * v[0] + v[1] * v[1]) + (v[2] * v[2] + v[3] * v[3]); }
        s = wave_sum(s);
        if (lane == 0) ((float*)(ws + WS_RSTD0))[m] = rsqrtf(s * (1.0f / D) + EPS);
    }
}

__device__ __forceinline__ void pool_phase(const Args& a, LAS unsigned char* lds, int vcu, int G) {
    int tid_ = threadIdx.x; asm volatile("" : "+v"(tid_));
    const int tid = tid_;
    LAS float* tile = (LAS float*)lds;
    const float* rstd0 = (const float*)(a.ws + WS_RSTD0);
    bf16_t* diff = (bf16_t*)(a.ws + WS_QB);
    for (int u = vcu; u < (T / 64) * 4; u += G) {
        const int rb = u >> 2, g = u & 3, t0 = rb * 64;
        const int s0 = t0 < TP ? (t0 & ~(SEQP - 1)) : (t0 & ~(SEQS - 1)), s1 = s0 + (t0 < TP ? SEQP : SEQS);
        const f32x4 gm = *(const f32x4*)(a.in[4] + g * 256 + (tid & 63) * 4);
#pragma unroll
        for (int i = 0; i < 10; ++i) {
            const int idx = tid + 512 * i, r = idx >> 6, c4 = idx & 63, grow = t0 - 8 + r;
            f32x4 v = (f32x4){0.f, 0.f, 0.f, 0.f};
            if (grow >= s0 && grow < s1) {
                const float* src = (grow < TP) ? a.in[0] + (size_t)grow * D : a.in[1] + (size_t)(grow - TP) * D;
                v = *(const f32x4*)(src + g * 256 + c4 * 4) * rstd0[grow] * gm;
            }
            *(LAS f32x4*)(tile + r * 256 + c4 * 4) = v;
        }
        __syncthreads();
        const int c2 = (tid & 127) * 2, rq = tid >> 7, hw = 1 << g;
        for (int r = 0; r < 16; ++r) {
            const int tl = rq * 16 + r, t = t0 + tl;
            const int lo = max(t - hw, s0), hi2 = min(t + hw, s1);
            f32x2 sum = (f32x2){0.f, 0.f};
            for (int j = -hw; j < hw; ++j) sum += *(const LAS f32x2*)(tile + (tl + 8 + j) * 256 + c2);
            const f32x2 ctr = *(const LAS f32x2*)(tile + (tl + 8) * 256 + c2);
            const float ic = 1.0f / (float)(hi2 - lo);
            *(unsigned*)(diff + (size_t)t * D + g * 256 + c2) = pk_bf16(sum[0] * ic - ctr[0], sum[1] * ic - ctr[1]);
        }
        __syncthreads();
    }
}

__device__ __forceinline__ void final_phase(const Args& a, int vcu, int G) {
    int tid_ = threadIdx.x; asm volatile("" : "+v"(tid_));
    const int tid = tid_, lane = tid & 63, wave = __builtin_amdgcn_readfirstlane(tid >> 6);
    const int gw = vcu * NWAVES + wave, NGW = G * NWAVES;
    f32x4 gn[4];
#pragma unroll
    for (int j = 0; j < 4; ++j) gn[j] = *((const f32x4*)a.in[18] + lane + 64 * j);
    for (int m = gw; m < T; m += NGW) {
        f32x4* row = (f32x4*)(a.out + (size_t)m * D) + lane;
        f32x4 v[4]; float s = 0.f;
#pragma unroll
        for (int j = 0; j < 4; ++j) { v[j] = row[64 * j]; s += (v[j][0] * v[j][0] + v[j][1] * v[j][1]) + (v[j][2] * v[j][2] + v[j][3] * v[j][3]); }
        const float rs = rsqrtf(wave_sum(s) * (1.0f / D) + EPS);
#pragma unroll
        for (int j = 0; j < 4; ++j) row[64 * j] = v[j] * rs * gn[j];
    }
}

enum { K_PRO = 0, K_POOL, K_G_RESID, K_G_ROW, K_G_UP, K_G_QKV, K_XATT, K_WATT, K_FINAL };
constexpr int NSTEPS = 27;
struct Step {
    int kind, sync;
    pg8::Gemm g;
    const float* base_lo; const float* base_hi; int split_row; const float* cscale;
    bf16_t* out; int ldc; const float* ssp; float cst; int tsplit; bf16_t* vt; int t_pm_stride, t_ld;
    int layer;
};

__device__ __forceinline__ Step make_step(int st, const Args& a) {
    unsigned char* ws = a.ws;
    Step s; s.kind = K_PRO; s.sync = 1; s.g = pg8::Gemm{nullptr, nullptr, D, D, D, 0, 0, 0, 0};
    s.base_lo = a.out; s.base_hi = a.out; s.split_row = 1 << 30; s.cscale = nullptr;
    s.out = nullptr; s.ldc = D; s.ssp = (const float*)(ws + WS_SSP); s.cst = 1.f; s.tsplit = 1 << 20; s.vt = nullptr; s.t_pm_stride = 0; s.t_ld = 0; s.layer = 0;
    bf16_t* XB = (bf16_t*)(ws + WS_XB); bf16_t* QB = (bf16_t*)(ws + WS_QB);
    int mlp = -1, xa = -1;
    if (st == 0) { s.kind = K_PRO; }
    else if (st == 1) { s.kind = K_POOL; }
    else if (st == 2) { s.kind = K_G_RESID; s.sync = 0; s.g = pg8::Gemm{QB, (const bf16_t*)(ws + WS_PW), D, 256, 256, 256, T / 256, 4, 0};
        s.base_lo = a.in[0]; s.base_hi = a.in[1]; s.split_row = TP; s.cscale = a.in[6]; }
    else if (st == 3 || st == 4) { const int L = st - 3; s.kind = K_G_ROW; s.sync = (st == 4); s.layer = L;
        s.g = pg8::Gemm{(const bf16_t*)(ws + WS_MB), (const bf16_t*)(ws + WS_WXKV) + (size_t)L * 2 * D * D, D, D, D, 0, NMEMROWS / 256, 8, 0};
        s.out = (bf16_t*)(ws + WS_KM) + (size_t)L * NMEMROWS * D; s.ldc = D; s.ssp = (const float*)(ws + WS_SSPM); s.cst = 1.f; s.tsplit = 4;
        s.vt = (bf16_t*)(ws + WS_VMT) + (size_t)L * NMEMROWS * D; s.t_pm_stride = D * 256; s.t_ld = 256; }
    else if (st >= 5 && st <= 7) { xa = st - 5; s.layer = 0; }
    else if (st >= 8 && st <= 13) { mlp = st - 8; s.layer = 0; }
    else if (st == 14) { s.kind = K_G_QKV; s.g = pg8::Gemm{XB, (const bf16_t*)(ws + WS_WQKV), D, D, D, 0, T / 256, 6, 0}; }
    else if (st == 15) { s.kind = K_WATT; }
    else if (st == 16) { s.kind = K_G_RESID; s.g = pg8::Gemm{QB, (const bf16_t*)(ws + WS_WAO), D, D, D, 0, T / 256, 4, 0}; }
    else if (st >= 17 && st <= 19) { xa = st - 17; s.layer = 1; }
    else if (st >= 20 && st <= 25) { mlp = st - 20; s.layer = 1; }
    else { s.kind = K_FINAL; s.sync = 0; }
    if (xa == 0) { s.kind = K_G_ROW; s.g = pg8::Gemm{XB, (const bf16_t*)(ws + WS_WXQ) + (size_t)s.layer * D * D, D, D, D, 0, T / 256, 4, 0};
        s.out = QB; s.ldc = D; s.cst = 0.0625f * LOG2E; }
    else if (xa == 1) { s.kind = K_XATT; }
    else if (xa == 2) { s.kind = K_G_RESID; s.g = pg8::Gemm{QB, (const bf16_t*)(ws + WS_WXO) + (size_t)s.layer * D * D, D, D, D, 0, T / 256, 4, 0}; }
    if (mlp >= 0) {
        const int c = mlp >> 1, pm0 = 64 * c;
        bf16_t* H = (bf16_t*)(ws + ((c & 1) ? WS_H1 : WS_H0)) - (size_t)pm0 * 256 * FF;
        if ((mlp & 1) == 0) { s.kind = K_G_UP; s.sync = 1; s.g = pg8::Gemm{XB, (const bf16_t*)(ws + WS_WUP) + (size_t)s.layer * D * FF, D, D, D, 0, 64, 16, pm0}; s.out = H; }
        else { s.kind = K_G_RESID; s.sync = (c == 2); s.g = pg8::Gemm{H, (const bf16_t*)(ws + WS_WDN) + (size_t)s.layer * D * FF, FF, FF, FF, 0, 64, 4, pm0}; }
    }
    return s;
}

__global__ void __launch_bounds__(NTHR, 2) fwd_megakernel(Args a) {
    extern __shared__ __attribute__((aligned(16))) unsigned char lds_raw[];
    LAS unsigned char* lds = (LAS unsigned char*)lds_raw;
    const int G = gridDim.x, bx = blockIdx.x;
    const int vcu = (G % 8 == 0) ? (bx % 8) * (G / 8) + bx / 8 : bx;
    unsigned char* ws = a.ws;
    for (int st = a.lo; st < a.hi; ++st) {
        const Step s = make_step(st, a);
        switch (s.kind) {
        case K_PRO: prologue_phase(a, lds, vcu, G); break;
        case K_POOL: pool_phase(a, lds, vcu, G); break;
        case K_G_RESID: { pg8::EpiResid E{s.base_lo, s.base_hi, s.split_row, a.out, (bf16_t*)(ws + WS_XB), (float*)(ws + WS_SSP), s.cscale};
            pg8::gemm_phase<pg8::EpiResid>(lds, s.g, G, bx, E); } break;
        case K_G_ROW: { pg8::EpiRowScale E{s.out, s.ldc, s.ssp, s.cst, s.tsplit, s.vt, s.t_pm_stride, s.t_ld};
            pg8::gemm_phase<pg8::EpiRowScale>(lds, s.g, G, bx, E); } break;
        case K_G_UP: { pg8::EpiUp E{s.out, s.ssp};
            pg8::gemm_phase<pg8::EpiUp>(lds, s.g, G, bx, E); } break;
        case K_G_QKV: { pg8::EpiQKV E{(bf16_t*)(ws + WS_QB), (bf16_t*)(ws + WS_KW), (bf16_t*)(ws + WS_VT), (const float*)(ws + WS_SSP), (const float*)(ws + WS_ROPE), (const float*)(ws + WS_ROPE) + SEQS * 32};
            pg8::gemm_phase<pg8::EpiQKV>(lds, s.g, G, bx, E); } break;
        case K_XATT: {
            const bf16_t* KM = (const bf16_t*)(ws + WS_KM) + (size_t)s.layer * NMEMROWS * D; const bf16_t* VMT = (const bf16_t*)(ws + WS_VMT) + (size_t)s.layer * NMEMROWS * D;
            for (int u = vcu; u < (T / 256) * 4; u += G) xattn_unit(lds, (bf16_t*)(ws + WS_QB), KM, VMT, u >> 2, u & 3);
        } break;
        case K_WATT: {
            for (int u = vcu; u < (T / 256) * 16; u += G) wattn_unit(lds, (bf16_t*)(ws + WS_QB), (const bf16_t*)(ws + WS_KW), (const bf16_t*)(ws + WS_VT), a.in[9], u >> 4, u & 15);
        } break;
        default: final_phase(a, vcu, G); break;
        }
        if (s.sync && st + 1 < a.hi) cg::this_grid().sync();
    }
}

constexpr int LDS_BYTES = 147456;
extern "C" void kernel_launch(void* const* d_in, const int* in_sizes, int n_in, void* d_out, int out_size, void* d_ws, size_t ws_size, hipStream_t stream) {
    static int grid = 0;
    if (grid == 0) {
        if (n_in != 19 || out_size != T * D || ws_size < WS_END) { fprintf(stderr, "kernel_launch: unexpected problem (n_in %d, out %d, ws %zu); nothing launched\n", n_in, out_size, ws_size); grid = -1; return; }
        int dev = 0, cus = 0, per_cu = 0;
        hipGetDevice(&dev); hipDeviceGetAttribute(&cus, hipDeviceAttributeMultiprocessorCount, dev);
        if (hipFuncSetAttribute((const void*)fwd_megakernel, hipFuncAttributeMaxDynamicSharedMemorySize, LDS_BYTES) != hipSuccess) { fprintf(stderr, "kernel_launch: hipFuncSetAttribute failed\n"); grid = -1; return; }
        if (hipOccupancyMaxActiveBlocksPerMultiprocessor(&per_cu, (const void*)fwd_megakernel, NTHR, LDS_BYTES) != hipSuccess || per_cu < 1) { fprintf(stderr, "kernel_launch: occupancy query says %d\n", per_cu); per_cu = 1; }
        (void)hipGetLastError();
        grid = cus * per_cu;
        fprintf(stderr, "kernel_launch: grid %d (%d CUs x %d)\n", grid, cus, per_cu);
    }
    if (grid < 0) return;
    Args a{};
    for (int i = 0; i < 19; ++i) a.in[i] = (const float*)d_in[i];
    a.out = (float*)d_out; a.ws = (unsigned char*)d_ws;
#if ONE_LAUNCH
    a.lo = 0; a.hi = NSTEPS;
    void* args[] = {&a};
    hipError_t e = hipLaunchCooperativeKernel((const void*)fwd_megakernel, dim3(grid), dim3(NTHR), args, LDS_BYTES, stream);
    if (e != hipSuccess) fprintf(stderr, "kernel_launch: cooperative launch failed: %s (grid %d)\n", hipGetErrorString(e), grid);
#else
    for (int st = 0; st < NSTEPS; ++st) {
        a.lo = st; a.hi = st + 1;
        hipLaunchKernelGGL(fwd_megakernel, dim3(grid), dim3(NTHR), LDS_BYTES, stream, a);
    }
#endif
}
```

```cpp
#include <hip/hip_runtime.h>
#include <hip/hip_cooperative_groups.h>
#include <cstdio>
#include <cstdint>
namespace cg = cooperative_groups;

#ifndef ONE_LAUNCH
#define ONE_LAUNCH 1
#endif
#ifndef PROBE
#define PROBE 0
#endif
#define M_GEMM ((1ull<<2)|(1ull<<3)|(1ull<<4)|(1ull<<5)|(1ull<<7)|(0x3full<<8)|(1ull<<14)|(1ull<<16)|(1ull<<17)|(1ull<<19)|(0x3full<<20))
#define M_ATT ((1ull<<6)|(1ull<<15)|(1ull<<18))
#define M_ELEM ((1ull<<0)|(1ull<<1)|(1ull<<26))
#define M_ALL ((1ull<<27)-1)
#ifndef PROBE_SET
#define PROBE_SET 1
#endif
#define BIT(i) (1ull << (i))
#if PROBE_SET == 1
#define P_A1W BIT(8)
#define P_A2W BIT(9)
#define P_BW 0ull
#define P_BS M_ALL
#elif PROBE_SET == 2
#define P_A1W BIT(15)
#define P_A2W BIT(6)
#define P_BW BIT(0)
#define P_BS 0ull
#elif PROBE_SET == 3
#define P_A1W BIT(7)
#define P_A2W BIT(5)
#define P_BW BIT(1)
#define P_BS 0ull
#elif PROBE_SET == 4
#define P_A1W BIT(14)
#define P_A2W BIT(2)
#define P_BW (BIT(3) | BIT(4))
#define P_BS 0ull
#elif PROBE_SET == 5
#define P_A1W BIT(26)
#define P_A2W BIT(16)
#define P_BW M_GEMM
#define P_BS 0ull
#elif PROBE_SET == 7
#define P_A1W BIT(0)
#define P_A2W 0ull
#define P_A1S 0ull
#define P_A2S BIT(0)
#define P_BW 0ull
#define P_BS BIT(1)
#elif PROBE_SET == 11
#define P_A1W M_GEMM
#define P_A2W 0ull
#define P_A1S 0ull
#define P_A2S M_ALL
#define P_BW M_ATT
#define P_BS 0ull
#elif PROBE_SET == 12
#define P_A1W BIT(0)
#define P_A2W BIT(1)
#define P_BW BIT(26)
#define P_BS 0ull
#elif PROBE_SET == 13
#define P_A1W 0ull
#define P_A2W 0ull
#define P_BW 0ull
#define P_BS 0ull
#elif PROBE_SET == 10
#define P_A1W BIT(9)
#define P_A2W BIT(13)
#define P_BW BIT(8)
#define P_BS 0ull
#elif PROBE_SET == 9
#define P_A1W 0ull
#define P_A2W 0ull
#define P_BW BIT(1)
#define P_BS BIT(1)
#elif PROBE_SET == 8
#define P_A1W BIT(1)
#define P_A2W 0ull
#define P_A1S 0ull
#define P_A2S BIT(4)
#define P_BW 0ull
#define P_BS (BIT(5)|BIT(7)|BIT(14)|BIT(16)|BIT(17)|BIT(19))
#else
#define P_A1W 0ull
#define P_A2W 0ull
#define P_A1S ((0x3full << 8) | (0x3full << 20))
#define P_A2S (BIT(6) | BIT(15) | BIT(18))
#define P_BW 0ull
#define P_BS (BIT(0) | BIT(1) | BIT(4))
#endif
#ifndef P_A1S
#define P_A1S 0ull
#define P_A2S 0ull
#endif

#define LAS __attribute__((address_space(3)))
typedef unsigned short bf16_t;
typedef short bf16x8 __attribute__((ext_vector_type(8)));
typedef float f32x4 __attribute__((ext_vector_type(4)));
typedef float f32x2 __attribute__((ext_vector_type(2)));
typedef float f32x16 __attribute__((ext_vector_type(16)));
typedef unsigned u32x4 __attribute__((ext_vector_type(4)));
typedef unsigned u32x2 __attribute__((ext_vector_type(2)));
typedef __bf16 bf16x2_t __attribute__((ext_vector_type(2)));

constexpr int D = 1024, FF = 4096, T = 49152, TP = 32768, SEQP = 2048, SEQS = 8192, NMEMROWS = 4608, NQKV = 1536;
constexpr float EPS = 1e-6f, LOG2E = 1.4426950408889634f;
constexpr int NWAVES = 8, NTHR = 512;

constexpr size_t MiB = 1u << 20;
constexpr size_t WS_PW = 1 * MiB, WS_WQKV = 2 * MiB, WS_WAO = 5 * MiB, WS_WXQ = 7 * MiB, WS_WXKV = 11 * MiB, WS_WXO = 19 * MiB, WS_WUP = 23 * MiB, WS_WDN = 39 * MiB;
constexpr size_t WS_ROPE = 55 * MiB, WS_RSTD0 = 57 * MiB, WS_SSP = 58 * MiB, WS_SSPM = 61 * MiB, WS_MB = 62 * MiB, WS_KM = 71 * MiB, WS_VMT = 89 * MiB, WS_XB = 108 * MiB;
constexpr size_t WS_BIG = 204 * MiB, WS_QB = WS_BIG, WS_KW = WS_BIG + 96 * MiB, WS_VT = WS_BIG + 120 * MiB, WS_H0 = WS_BIG, WS_H1 = WS_BIG + 128 * MiB, WS_END = WS_BIG + 256 * MiB;

__device__ __forceinline__ unsigned pk_bf16(float lo, float hi) { f32x2 v = {lo, hi}; bf16x2_t b = __builtin_convertvector(v, bf16x2_t); return __builtin_bit_cast(unsigned, b); }
__device__ __forceinline__ float rstd_from(const float* p) {
    const f32x4 s = *(const f32x4*)p;
    return rsqrtf(((s[0] + s[1]) + (s[2] + s[3])) * (1.0f / D) + EPS);
}
__device__ __forceinline__ float wave_sum(float v) {
#pragma unroll
    for (int o = 1; o < 64; o <<= 1) v += __shfl_xor(v, o);
    return v;
}

namespace pg8 {
constexpr int BM = 256, BK = 64, HALF = 128, HTB = HALF * BK * 2, STAGE_BYTES = 8 * HTB, NXCD = 8, WGM = 8;
__host__ __device__ __forceinline__ int lds_byte(int r, int c) { const int st = (r >> 4) * 2 + (c >> 5), rr = r & 15, cc = c & 31, ob = rr * 64 + cc * 2; return st * 1024 + (ob ^ (((ob >> 9) & 1) << 5)); }
__host__ __device__ __forceinline__ void stage_rc(int b, int& R, int& C) { const int st = b / 1024, sb = b % 1024, swz = sb ^ (((sb >> 9) & 1) << 5); R = (st >> 1) * 16 + swz / 64; C = (st & 1) * 32 + (swz % 64) / 2; }
__host__ __device__ __forceinline__ int perm32(int rho) { const int n = rho >> 4, i = rho & 15; return 8 * (i >> 2) + 4 * n + (i & 3); }

struct Unit { int pm, pn; };
struct Gemm { const bf16_t* A; const bf16_t* Bt; int lda, ldb, K, a_pn_off, nM, nN, pm0, u_lo, u_cnt, c_rot; };

struct Order {
    int nM, nN, nwg, G, c, pm0, u_lo, u_cnt;
    __device__ __forceinline__ void init(const Gemm& g, int G_, int c_) { nM = g.nM; nN = g.nN; nwg = nM * nN; G = G_; pm0 = g.pm0; u_lo = g.u_lo; u_cnt = g.u_cnt ? g.u_cnt : nwg;
        const int cc = c_ - g.c_rot; c = cc < 0 ? cc + G_ : cc; }
    __device__ __forceinline__ bool next(int i, Unit& u) const {
        const long L = (long)i * G + c; if (L >= u_cnt) return false;
        int wgid = (int)L + u_lo; { const int q = nwg / NXCD, r = nwg % NXCD, xcd = wgid % NXCD, off = wgid / NXCD; wgid = (xcd < r ? xcd * (q + 1) : r * (q + 1) + (xcd - r) * q) + off; }
        const int nig = WGM * nN, gid = wgid / nig, fm = gid * WGM, gsz = (nM - fm) < WGM ? (nM - fm) : WGM;
        u.pm = fm + ((wgid % nig) % gsz) + pm0; u.pn = (wgid % nig) / gsz; return true;
    }
};

template <class Epi>
__device__ __forceinline__ void gemm_phase(LAS unsigned char* lds, const Gemm g, const int G, const int cblk, const Epi& E) {
    int tid_ = threadIdx.x; asm volatile("" : "+v"(tid_));
    const int tid = tid_, wid = __builtin_amdgcn_readfirstlane(tid >> 6), lane = tid & 63, wr = wid >> 2, wc = wid & 3, fr = lane & 15, fq = lane >> 4;
    const int nt = g.K / BK;
    Order S; S.init(g, G, cblk);
    unsigned voffA[2], voffB[2];
#pragma unroll
    for (int i = 0; i < 2; ++i) { int R, C; stage_rc(tid * 16 + i * 8192, R, C); const int Rb = (R & ~31) + perm32(R & 31);
        voffA[i] = (unsigned)(R * g.lda + C) * 2u; voffB[i] = (unsigned)(Rb * g.ldb + C) * 2u; }
    const size_t kstep = (size_t)(BK * 2);
    const size_t hstepA = (size_t)HALF * g.lda * 2, hstepB = (size_t)HALF * g.ldb * 2;
    const unsigned ldsw = (unsigned)wid * 1024u;
    const int aoff = lds_byte(wr * 64 + fr, fq * 8), boff = lds_byte(wc * 32 + fr, fq * 8);
#define PG8_UA(u) ((const char*)g.A + ((size_t)(u).pm * BM * g.lda + (size_t)(u).pn * g.a_pn_off) * 2)
#define PG8_UB(u) ((const char*)g.Bt + (size_t)(u).pn * BM * g.ldb * 2)
#define PG8_SA(b, h) (((b) * 2 + (h)) * HTB)
#define PG8_SB(b, h) ((4 + (b) * 2 + (h)) * HTB)
#define PG8_STAGE(bufoff, gbase, voff) do { _Pragma("unroll") for (int _i = 0; _i < 2; ++_i) \
        __builtin_amdgcn_global_load_lds((const unsigned*)((const char*)(gbase) + (voff)[_i]), (LAS unsigned*)(lds + (bufoff) + ldsw + _i * 8192), 16, 0, 0); } while (0)
#define PG8_LDA(dst, b, h) do { _Pragma("unroll") for (int m = 0; m < 4; ++m) _Pragma("unroll") for (int k = 0; k < 2; ++k) dst[m][k] = *(const LAS bf16x8*)(lds + PG8_SA(b, h) + aoff + m * 2048 + k * 1024); } while (0)
#define PG8_LDB(dst, b, h) do { _Pragma("unroll") for (int n = 0; n < 2; ++n) _Pragma("unroll") for (int k = 0; k < 2; ++k) dst[n][k] = *(const LAS bf16x8*)(lds + PG8_SB(b, h) + boff + n * 2048 + k * 1024); } while (0)
#define PG8_MMA(ai, bj, At, Bt) do { __builtin_amdgcn_s_setprio(1); _Pragma("unroll") for (int m = 0; m < 4; ++m) _Pragma("unroll") for (int n = 0; n < 2; ++n) _Pragma("unroll") for (int k = 0; k < 2; ++k) \
        acc[ai][bj][m][n] = __builtin_amdgcn_mfma_f32_16x16x32_bf16(Bt[n][k], At[m][k], acc[ai][bj][m][n], 0, 0, 0); __builtin_amdgcn_s_setprio(0); } while (0)
#define PG8_WAIT_V(n) asm volatile("s_waitcnt vmcnt(" #n ")" ::: "memory")
#define PG8_WAIT_L(n) asm volatile("s_waitcnt lgkmcnt(" #n ")" ::: "memory")
#define PG8_BAR __builtin_amdgcn_s_barrier()
#define PG8_SCHED __builtin_amdgcn_sched_barrier(0)
    Unit cur, nxt; int ui = 0;
    if (!S.next(0, cur)) return;
    if (E.ssp_rows()) {
        LAS float* tab = (LAS float*)(lds + STAGE_BYTES + 8192);
        Unit uu;
        for (int i = 0; i < 8 && S.next(i, uu); ++i) { if (tid < 256) tab[i * 256 + tid] = rstd_from(E.ssp_rows() + (size_t)(uu.pm * BM + tid) * 4); }
        asm volatile("s_waitcnt vmcnt(0) lgkmcnt(0)\n\ts_barrier" ::: "memory");
    }
    f32x4 acc[2][2][4][2];
#pragma unroll
    for (int a = 0; a < 2; ++a)
#pragma unroll
        for (int b = 0; b < 2; ++b)
#pragma unroll
            for (int m = 0; m < 4; ++m)
#pragma unroll
                for (int n = 0; n < 2; ++n) acc[a][b][m][n] = (f32x4){0.f, 0.f, 0.f, 0.f};
    bf16x8 At[4][2], B0[2][2], B1[2][2];
    const char* cA = PG8_UA(cur); const char* cB = PG8_UB(cur);
    PG8_STAGE(PG8_SB(0, 0), cB, voffB); PG8_STAGE(PG8_SB(0, 1), cB + hstepB, voffB); PG8_STAGE(PG8_SA(0, 0), cA, voffA); PG8_STAGE(PG8_SA(0, 1), cA + hstepA, voffA);
    if (wr == 1) PG8_BAR;
    PG8_WAIT_V(2); PG8_BAR;
    PG8_STAGE(PG8_SB(1, 0), cB + kstep, voffB); PG8_STAGE(PG8_SA(1, 0), cA + kstep, voffA); PG8_STAGE(PG8_SB(1, 1), cB + hstepB + kstep, voffB);
    PG8_WAIT_V(6); PG8_BAR;
    for (;;) {
        const bool has_next = S.next(ui + 1, nxt);
        const char* nA = has_next ? PG8_UA(nxt) : cA; const char* nB = has_next ? PG8_UB(nxt) : cB;
        for (int t = 0; t < nt; t += 2) {
            const bool last = (t == nt - 2);
            const char* a1 = cA + (size_t)(t + 1) * kstep;
            const char* a2 = last ? nA : cA + (size_t)(t + 2) * kstep; const char* b2 = last ? nB : cB + (size_t)(t + 2) * kstep;
            const char* a3 = a2 + kstep; const char* b3 = b2 + kstep;
            PG8_LDB(B0, 0, 0); PG8_LDB(B1, 0, 1); PG8_SCHED; PG8_LDA(At, 0, 0); PG8_STAGE(PG8_SA(1, 1), a1 + hstepA, voffA);
            PG8_WAIT_V(8); PG8_WAIT_L(0); PG8_BAR; PG8_MMA(0, 0, At, B0); PG8_MMA(0, 1, At, B1); PG8_BAR; PG8_SCHED;
            PG8_LDA(At, 0, 1); PG8_STAGE(PG8_SB(0, 0), b2, voffB); PG8_STAGE(PG8_SB(0, 1), b2 + hstepB, voffB); PG8_STAGE(PG8_SA(0, 0), a2, voffA);
            PG8_WAIT_V(8); PG8_WAIT_L(0); PG8_BAR; PG8_MMA(1, 0, At, B0); PG8_MMA(1, 1, At, B1); PG8_BAR; PG8_SCHED;
            PG8_LDB(B0, 1, 0); PG8_LDB(B1, 1, 1); PG8_SCHED; PG8_LDA(At, 1, 0); PG8_STAGE(PG8_SA(0, 1), a2 + hstepA, voffA);
            PG8_WAIT_V(8); PG8_WAIT_L(0); PG8_BAR; PG8_MMA(0, 0, At, B0); PG8_MMA(0, 1, At, B1); PG8_BAR; PG8_SCHED;
            PG8_LDA(At, 1, 1); PG8_STAGE(PG8_SB(1, 0), b3, voffB); PG8_STAGE(PG8_SB(1, 1), b3 + hstepB, voffB); PG8_STAGE(PG8_SA(1, 0), a3, voffA);
            PG8_WAIT_V(8); PG8_WAIT_L(0); PG8_BAR; PG8_MMA(1, 0, At, B0); PG8_MMA(1, 1, At, B1); PG8_BAR; PG8_SCHED;
        }
        if (wr == 0) PG8_BAR;
        E(acc, cur, wr, wc, fr, fq, (const LAS float*)(lds + STAGE_BYTES + 8192) + (ui & 7) * 256);
        if (!has_next) break;
#pragma unroll
        for (int a = 0; a < 2; ++a)
#pragma unroll
            for (int b = 0; b < 2; ++b)
#pragma unroll
                for (int m = 0; m < 4; ++m)
#pragma unroll
                    for (int n = 0; n < 2; ++n) acc[a][b][m][n] = (f32x4){0.f, 0.f, 0.f, 0.f};
        cur = nxt; cA = nA; cB = nB; ++ui;
        if (wr == 1) PG8_BAR;
    }
    PG8_WAIT_V(0);
    PG8_BAR;
#undef PG8_UA
#undef PG8_UB
#undef PG8_SA
#undef PG8_SB
#undef PG8_STAGE
#undef PG8_LDA
#undef PG8_LDB
#undef PG8_MMA
#undef PG8_WAIT_V
#undef PG8_WAIT_L
#undef PG8_BAR
#undef PG8_SCHED
}

struct EpiResid {
    const float* base_lo; const float* base_hi; int split_row; int base_f32;
    bf16_t* xb; float* ssp; const float* cscale; LAS float* red;
    __device__ __forceinline__ const float* ssp_rows() const { return nullptr; }
    __device__ __forceinline__ void operator()(const f32x4 (&acc)[2][2][4][2], const Unit& u, int wr, int wc, int fr, int fq, const LAS float* rstab) const {
        const int rl0 = wr * 64 + fr, col0 = u.pn * BM + wc * 32 + 8 * fq;
        f32x4 cs[2][2];
#pragma unroll
        for (int bj = 0; bj < 2; ++bj)
#pragma unroll
            for (int n = 0; n < 2; ++n) cs[bj][n] = cscale ? *(const f32x4*)(cscale + col0 + bj * HALF + 4 * n) : (f32x4){1.f, 1.f, 1.f, 1.f};
        const float* bp = (u.pm * BM < split_row) ? base_lo : (base_hi - (size_t)split_row * D);
#define RESID_BODY(m_, bj_, b0_, b1_) do { \
            const f32x4 v0 = (b0_) + acc[ai][bj_][m_][0] * cs[bj_][0], v1 = (b1_) + acc[ai][bj_][m_][1] * cs[bj_][1]; \
            ssr[m_] += (v0[0] * v0[0] + v0[1] * v0[1]) + (v0[2] * v0[2] + v0[3] * v0[3]) + (v1[0] * v1[0] + v1[1] * v1[1]) + (v1[2] * v1[2] + v1[3] * v1[3]); \
            u32x4 w; w.x = pk_bf16(v0[0], v0[1]); w.y = pk_bf16(v0[2], v0[3]); w.z = pk_bf16(v1[0], v1[1]); w.w = pk_bf16(v1[2], v1[3]); \
            *(u32x4*)(xb + offa + (size_t)(m_) * 16 * D + (bj_) * HALF) = w; } while (0)
#pragma unroll
        for (int ai = 0; ai < 2; ++ai) {
            int rla = rl0 + ai * HALF; asm volatile("" : "+v"(rla) :: "memory");
            const size_t offa = (size_t)(u.pm * BM + rla) * D + col0;
            float ssr[4] = {0.f, 0.f, 0.f, 0.f};
            if (!base_f32) {
                u32x4 pre[4][2];
#pragma unroll
                for (int m = 0; m < 4; ++m)
#pragma unroll
                    for (int bj = 0; bj < 2; ++bj) pre[m][bj] = *(const u32x4*)(xb + offa + (size_t)m * 16 * D + bj * HALF);
#pragma unroll
                for (int m = 0; m < 4; ++m)
#pragma unroll
                    for (int bj = 0; bj < 2; ++bj) { const u32x4 w0 = pre[m][bj];
                        const f32x4 b0 = (f32x4){__uint_as_float(w0.x << 16), __uint_as_float(w0.x & 0xffff0000u), __uint_as_float(w0.y << 16), __uint_as_float(w0.y & 0xffff0000u)};
                        const f32x4 b1 = (f32x4){__uint_as_float(w0.z << 16), __uint_as_float(w0.z & 0xffff0000u), __uint_as_float(w0.w << 16), __uint_as_float(w0.w & 0xffff0000u)};
                        RESID_BODY(m, bj, b0, b1); }
            } else {
#pragma unroll
                for (int mp = 0; mp < 2; ++mp) {
                    f32x4 pf[2][2][2];
#pragma unroll
                    for (int mm = 0; mm < 2; ++mm)
#pragma unroll
                        for (int bj = 0; bj < 2; ++bj) { const float* p = bp + offa + (size_t)(2 * mp + mm) * 16 * D + bj * HALF; pf[mm][bj][0] = *(const f32x4*)p; pf[mm][bj][1] = *(const f32x4*)(p + 4); }
#pragma unroll
                    for (int mm = 0; mm < 2; ++mm)
#pragma unroll
                        for (int bj = 0; bj < 2; ++bj) RESID_BODY(2 * mp + mm, bj, pf[mm][bj][0], pf[mm][bj][1]);
                    asm volatile("" ::: "memory");
                }
            }
#pragma unroll
            for (int m = 0; m < 4; ++m) { float ss = ssr[m]; ss += __shfl_xor(ss, 16); ss += __shfl_xor(ss, 32); if (fq == 0) red[(rla + m * 16) * 4 + wc] = ss; }
        }
#undef RESID_BODY
        asm volatile("s_waitcnt lgkmcnt(0)\n\ts_barrier" ::: "memory");
        const int t = threadIdx.x;
        if (t < 256) { const f32x4 p = *(const LAS f32x4*)(red + t * 4); ssp[(size_t)(u.pm * BM + t) * 4 + u.pn] = (p[0] + p[1]) + (p[2] + p[3]); }
    }
};
struct EpiRowScale {
    bf16_t* out; int ldc; const float* ssp; float cst; int tsplit; bf16_t* vt; int t_pm_stride, t_ld;
    __device__ __forceinline__ const float* ssp_rows() const { return ssp; }
    __device__ __forceinline__ void operator()(const f32x4 (&acc)[2][2][4][2], const Unit& u, int wr, int wc, int fr, int fq, const LAS float* rstab) const {
        const int rl0 = wr * 64 + fr, col0 = u.pn * BM + wc * 32 + 8 * fq;
        const bool tr = u.pn >= tsplit;
        float rs[8];
#pragma unroll
        for (int i = 0; i < 8; ++i) rs[i] = rstab[rl0 + (i >> 2) * HALF + (i & 3) * 16] * cst;
#pragma unroll
        for (int ai = 0; ai < 2; ++ai)
#pragma unroll
            for (int m = 0; m < 4; ++m) {
                int rl = rl0 + ai * HALF + m * 16; asm volatile("" : "+v"(rl) :: "memory");
                const int row = u.pm * BM + rl;
#pragma unroll
                for (int bj = 0; bj < 2; ++bj) {
                    const f32x4 v0 = acc[ai][bj][m][0] * rs[ai * 4 + m], v1 = acc[ai][bj][m][1] * rs[ai * 4 + m];
                    u32x4 w; w.x = pk_bf16(v0[0], v0[1]); w.y = pk_bf16(v0[2], v0[3]); w.z = pk_bf16(v1[0], v1[1]); w.w = pk_bf16(v1[2], v1[3]);
                    if (!tr) *(u32x4*)(out + (size_t)row * ldc + col0 + bj * HALF) = w;
                    else { bf16_t* p = vt + (size_t)u.pm * t_pm_stride + (size_t)(col0 - tsplit * BM + bj * HALF) * t_ld + rl;
                        p[0] = (bf16_t)w.x; p[(size_t)t_ld] = (bf16_t)(w.x >> 16); p[(size_t)2 * t_ld] = (bf16_t)w.y; p[(size_t)3 * t_ld] = (bf16_t)(w.y >> 16);
                        p[(size_t)4 * t_ld] = (bf16_t)w.z; p[(size_t)5 * t_ld] = (bf16_t)(w.z >> 16); p[(size_t)6 * t_ld] = (bf16_t)w.w; p[(size_t)7 * t_ld] = (bf16_t)(w.w >> 16); }
                }
            }
    }
};
struct EpiUp {
    bf16_t* out; const float* ssp;
    __device__ __forceinline__ const float* ssp_rows() const { return ssp; }
    __device__ __forceinline__ void operator()(const f32x4 (&acc)[2][2][4][2], const Unit& u, int wr, int wc, int fr, int fq, const LAS float* rstab) const {
        const int row0 = u.pm * BM + wr * 64 + fr, col0 = u.pn * BM + wc * 32 + 8 * fq;
        float rs[8];
#pragma unroll
        for (int i = 0; i < 8; ++i) rs[i] = rstab[wr * 64 + fr + (i >> 2) * HALF + (i & 3) * 16];
#pragma unroll
        for (int ai = 0; ai < 2; ++ai)
#pragma unroll
            for (int m = 0; m < 4; ++m) {
                int row = row0 + ai * HALF + m * 16; asm volatile("" : "+v"(row) :: "memory");
#pragma unroll
                for (int bj = 0; bj < 2; ++bj) {
                    f32x4 v0 = acc[ai][bj][m][0] * rs[ai * 4 + m], v1 = acc[ai][bj][m][1] * rs[ai * 4 + m];
#pragma unroll
                    for (int e = 0; e < 4; ++e) { v0[e] = fmaxf(v0[e], 0.f); v0[e] *= v0[e]; v1[e] = fmaxf(v1[e], 0.f); v1[e] *= v1[e]; }
                    u32x4 w; w.x = pk_bf16(v0[0], v0[1]); w.y = pk_bf16(v0[2], v0[3]); w.z = pk_bf16(v1[0], v1[1]); w.w = pk_bf16(v1[2], v1[3]);
                    *(u32x4*)(out + (size_t)row * FF + col0 + bj * HALF) = w;
                }
            }
    }
};
struct EpiQKV {
    bf16_t* qb; bf16_t* kw; bf16_t* vt; const float* ssp; const float* ropec; const float* ropes;
    __device__ __forceinline__ const float* ssp_rows() const { return ssp; }
    __device__ __forceinline__ void operator()(const f32x4 (&acc)[2][2][4][2], const Unit& u, int wr, int wc, int fr, int fq, const LAS float* rstab) const {
        const int row0 = u.pm * BM + wr * 64 + fr, colt = wc * 32 + 8 * fq;
        const int dd = 16 * (wc & 1) + 4 * fq;
        float rs[8];
#pragma unroll
        for (int i = 0; i < 8; ++i) rs[i] = rstab[wr * 64 + fr + (i >> 2) * HALF + (i & 3) * 16];
        if (u.pn < 5) {
            const float qs = (u.pn < 4 ? 0.125f * LOG2E : 1.0f);
#pragma unroll
            for (int ai = 0; ai < 2; ++ai) {
                int rowa = row0 + ai * HALF; asm volatile("" : "+v"(rowa) :: "memory");
                f32x4 c[4], sn[4];
#pragma unroll
                for (int m = 0; m < 4; ++m) { const int row = rowa + m * 16; const int pos = row < TP ? (row & (SEQP - 1)) : (row & (SEQS - 1));
                    c[m] = *(const f32x4*)(ropec + pos * 32 + dd); sn[m] = *(const f32x4*)(ropes + pos * 32 + dd); }
#pragma unroll
                for (int m = 0; m < 4; ++m) {
                    const int row = rowa + m * 16; const float sc = rs[ai * 4 + m] * qs;
#pragma unroll
                    for (int bj = 0; bj < 2; ++bj) {
                        const f32x4 x1 = acc[ai][bj][m][0] * sc, x2 = acc[ai][bj][m][1] * sc;
                        const f32x4 o1 = x1 * c[m] - x2 * sn[m], o2 = x2 * c[m] + x1 * sn[m];
                        u32x4 w; w.x = pk_bf16(o1[0], o1[1]); w.y = pk_bf16(o1[2], o1[3]); w.z = pk_bf16(o2[0], o2[1]); w.w = pk_bf16(o2[2], o2[3]);
                        if (u.pn < 4) *(u32x4*)(qb + (size_t)row * D + u.pn * BM + colt + bj * HALF) = w;
                        else *(u32x4*)(kw + (size_t)row * 256 + colt + bj * HALF) = w;
                    }
                }
            }
        } else {
#pragma unroll
            for (int ai = 0; ai < 2; ++ai)
#pragma unroll
                for (int m = 0; m < 4; ++m) {
                    int row = row0 + ai * HALF + m * 16; asm volatile("" : "+v"(row) :: "memory");
#pragma unroll
                    for (int bj = 0; bj < 2; ++bj) {
                        const f32x4 v0 = acc[ai][bj][m][0] * rs[ai * 4 + m], v1 = acc[ai][bj][m][1] * rs[ai * 4 + m];
                        u32x4 w; w.x = pk_bf16(v0[0], v0[1]); w.y = pk_bf16(v0[2], v0[3]); w.z = pk_bf16(v1[0], v1[1]); w.w = pk_bf16(v1[2], v1[3]);
                        bf16_t* p = vt + (size_t)(colt + bj * HALF) * T + row;
                        p[0] = (bf16_t)w.x; p[(size_t)T] = (bf16_t)(w.x >> 16); p[(size_t)2 * T] = (bf16_t)w.y; p[(size_t)3 * T] = (bf16_t)(w.y >> 16);
                        p[(size_t)4 * T] = (bf16_t)w.z; p[(size_t)5 * T] = (bf16_t)(w.z >> 16); p[(size_t)6 * T] = (bf16_t)w.w; p[(size_t)7 * T] = (bf16_t)(w.w >> 16);
                    }
                }
        }
    }
};
}

#define MFMA32(a, b, c) __builtin_amdgcn_mfma_f32_32x32x16_bf16((a), (b), (c), 0, 0, 0)
#define WG_BAR_LDS() asm volatile("s_waitcnt lgkmcnt(0)\n\ts_barrier" ::: "memory")
__device__ __forceinline__ int swap23(int r) { return (r & 0x13) | ((r & 4) << 1) | ((r & 8) >> 1); }
__device__ __forceinline__ bf16x8 pack8(const f32x16& x, int s) {
    u32x4 p; p.x = pk_bf16(x[8 * s + 0], x[8 * s + 1]); p.y = pk_bf16(x[8 * s + 2], x[8 * s + 3]); p.z = pk_bf16(x[8 * s + 4], x[8 * s + 5]); p.w = pk_bf16(x[8 * s + 6], x[8 * s + 7]);
    return __builtin_bit_cast(bf16x8, p);
}
__device__ __forceinline__ float max3(float a, float b, float c) { return __builtin_fmaxf(__builtin_fmaxf(a, b), c); }
__device__ __forceinline__ float vmax16(const f32x16& x) {
    float a = max3(x[0], x[1], x[2]), b = max3(x[3], x[4], x[5]), c = max3(x[6], x[7], x[8]), d = max3(x[9], x[10], x[11]);
    a = max3(a, x[12], x[13]); b = max3(b, x[14], x[15]);
    return __builtin_fmaxf(max3(a, b, c), d);
}

constexpr int XA_KP = 144, XA_VP = 528, XA_BUF = 256 * XA_KP;
__device__ __forceinline__ void xattn_unit(LAS unsigned char* lds, bf16_t* QO, const bf16_t* KM, const bf16_t* VMT, int qt, int h) {
    int tid_ = threadIdx.x; asm volatile("" : "+v"(tid_));
    const int tid = tid_, lane = tid & 63, wid = __builtin_amdgcn_readfirstlane(tid >> 6), r32 = lane & 31, hi = lane >> 5;
    const int seq = qt < 128 ? (qt >> 3) : 16 + ((qt - 128) >> 5);
    const bf16_t* Kg = KM + (size_t)(seq * 256) * D + h * 256;
    const bf16_t* Vg = VMT + ((size_t)seq * D + h * 256) * 256;
    bf16_t* Qg = QO + (size_t)(qt * 256 + wid * 32 + r32) * D + h * 256;
    u32x4 st[4];
#define XA_LOADK(c) do { _Pragma("unroll") for (int i = 0; i < 4; ++i) { const int ch = tid + 512 * i, row = ch >> 3, c16 = ch & 7; st[i] = *(const u32x4*)(Kg + (size_t)row * D + (c) * 64 + c16 * 8); } } while (0)
#define XA_LOADV(c) do { _Pragma("unroll") for (int i = 0; i < 4; ++i) { const int ch = tid + 512 * i, row = ch >> 5, c16 = ch & 31; st[i] = *(const u32x4*)(Vg + (size_t)((c) * 64 + row) * 256 + c16 * 8); } } while (0)
#define XA_WRK(buf) do { _Pragma("unroll") for (int i = 0; i < 4; ++i) { const int ch = tid + 512 * i, row = ch >> 3, c16 = ch & 7; *(LAS u32x4*)(lds + (buf) * XA_BUF + row * XA_KP + c16 * 16) = st[i]; } } while (0)
#define XA_WRV(buf) do { _Pragma("unroll") for (int i = 0; i < 4; ++i) { const int ch = tid + 512 * i, row = ch >> 5, c16 = ch & 31; *(LAS u32x4*)(lds + (buf) * XA_BUF + row * XA_VP + c16 * 16) = st[i]; } } while (0)
    XA_LOADK(0); XA_WRK(0); WG_BAR_LDS();
    f32x16 sc[8];
#pragma unroll
    for (int kb = 0; kb < 8; ++kb)
#pragma unroll
        for (int r = 0; r < 16; ++r) sc[kb][r] = 0.f;
    const int koff = swap23(r32) * XA_KP + hi * 16;
    bf16x8 qf[4];
#pragma unroll
    for (int ds = 0; ds < 4; ++ds) qf[ds] = *(const bf16x8*)(Qg + ds * 16 + hi * 8);
#pragma unroll 1
    for (int c = 0; c < 4; ++c) {
        if (c < 3) XA_LOADK(c + 1); else XA_LOADV(0);
        const LAS unsigned char* kb_base = lds + (c & 1) * XA_BUF + koff;
        {
            bf16x8 kf[2][4];
#pragma unroll
            for (int j = 0; j < 4; ++j) kf[0][j] = *(const LAS bf16x8*)(kb_base + j * 32 * XA_KP);
#pragma unroll
            for (int g = 0; g < 8; ++g) {
                if (g < 7) {
#pragma unroll
                    for (int j = 0; j < 4; ++j) kf[(g + 1) & 1][j] = *(const LAS bf16x8*)(kb_base + (4 * ((g + 1) & 1) + j) * 32 * XA_KP + ((g + 1) >> 1) * 32);
                }
                __builtin_amdgcn_sched_barrier(0);
#pragma unroll
                for (int j = 0; j < 4; ++j) sc[4 * (g & 1) + j] = MFMA32(kf[g & 1][j], qf[g >> 1], sc[4 * (g & 1) + j]);
                __builtin_amdgcn_sched_barrier(0);
            }
        }
        if (c < 3) {
#pragma unroll
            for (int ds = 0; ds < 4; ++ds) qf[ds] = *(const bf16x8*)(Qg + (c + 1) * 64 + ds * 16 + hi * 8);
        }
        if (c < 3) XA_WRK((c + 1) & 1); else XA_WRV(0);
        WG_BAR_LDS();
    }
    float mx = vmax16(sc[0]);
#pragma unroll
    for (int kb = 1; kb < 8; ++kb) mx = fmaxf(mx, vmax16(sc[kb]));
    mx = fmaxf(mx, __shfl_xor(mx, 32));
    float l = 0.f;
#pragma unroll
    for (int kb = 0; kb < 8; ++kb)
#pragma unroll
        for (int r = 0; r < 16; ++r) { const float p = __builtin_amdgcn_exp2f(sc[kb][r] - mx); sc[kb][r] = p; l += p; }
    l += __shfl_xor(l, 32);
    const float inv = 1.0f / l;
    bf16x8 pf[16];
#pragma unroll
    for (int kb = 0; kb < 8; ++kb) { pf[2 * kb] = pack8(sc[kb], 0); pf[2 * kb + 1] = pack8(sc[kb], 1); }
    const int voff = r32 * XA_VP + hi * 16;
#pragma unroll 1
    for (int c = 0; c < 4; ++c) {
        if (c < 3) XA_LOADV(c + 1);
        f32x16 o[2];
#pragma unroll
        for (int db = 0; db < 2; ++db)
#pragma unroll
            for (int r = 0; r < 16; ++r) o[db][r] = 0.f;
        const LAS unsigned char* vb_base = lds + (c & 1) * XA_BUF + voff;
        {
            bf16x8 vf[2][4];
#pragma unroll
            for (int j = 0; j < 4; ++j) vf[0][j] = *(const LAS bf16x8*)(vb_base + (j & 1) * 32 * XA_VP + (j >> 1) * 32);
#pragma unroll
            for (int g = 0; g < 8; ++g) {
                if (g < 7) {
#pragma unroll
                    for (int j = 0; j < 4; ++j) vf[(g + 1) & 1][j] = *(const LAS bf16x8*)(vb_base + (j & 1) * 32 * XA_VP + (2 * (g + 1) + (j >> 1)) * 32);
                }
                __builtin_amdgcn_sched_barrier(0);
#pragma unroll
                for (int j = 0; j < 4; ++j) o[j & 1] = MFMA32(vf[g & 1][j], pf[2 * g + (j >> 1)], o[j & 1]);
                __builtin_amdgcn_sched_barrier(0);
            }
        }
#pragma unroll
        for (int db = 0; db < 2; ++db)
#pragma unroll
            for (int gq = 0; gq < 4; ++gq) {
                u32x2 w; w.x = pk_bf16(o[db][4 * gq] * inv, o[db][4 * gq + 1] * inv); w.y = pk_bf16(o[db][4 * gq + 2] * inv, o[db][4 * gq + 3] * inv);
                *(u32x2*)(Qg + c * 64 + db * 32 + gq * 8 + hi * 4) = w;
            }
        if (c < 3) XA_WRV((c + 1) & 1);
        WG_BAR_LDS();
    }
#undef XA_LOADK
#undef XA_LOADV
#undef XA_WRK
#undef XA_WRV
}

constexpr int WA_P = 144, WA_TB = 64 * WA_P;
struct WaUnit { int q0, t_lo, t_hi, hq; };
__device__ __forceinline__ WaUnit wa_unit(int u, int wid) {
    WaUnit w; const int qt = u >> 3; w.hq = 2 * (u & 7) + (wid >> 2);
    w.q0 = qt * 128;
    const int S = w.q0 < TP ? SEQP : SEQS;
    const int q0s = w.q0 < TP ? (w.q0 & (SEQP - 1)) : (w.q0 & (SEQS - 1));
    w.t_lo = (q0s == 0) ? 2 : 0; w.t_hi = (q0s + 128 == S) ? 3 : 5;
    return w;
}
__device__ __forceinline__ void wattn_phase(LAS unsigned char* lds, bf16_t* QO, const bf16_t* KW, const bf16_t* VT, const float* sinks, int vcu, int G) {
    int tid_ = threadIdx.x; asm volatile("" : "+v"(tid_));
    const int tid = tid_, lane = tid & 63, wid = __builtin_amdgcn_readfirstlane(tid >> 6), r32 = lane & 31, hi = lane >> 5;
    constexpr int NU = (T / 128) * 8;
    const int wj = wid & 3, tw_lo = wj >> 1, tw_hi = (wj >> 1) + 4;
    const int srow = tid >> 3, sc16 = tid & 7;
    const int soff = srow * WA_P + sc16 * 16;
    const int koff = swap23(r32) * WA_P + hi * 16, voff = r32 * WA_P + hi * 16;
    const int qrel = wj * 32 + r32;
#define WA_KG(w, t) (KW + (size_t)((w).q0 - 128 + (t) * 64 + srow) * 256 + ((w).hq >> 2) * 64 + sc16 * 8)
#define WA_VG(w, t) (VT + (size_t)(((w).hq >> 2) * 64 + srow) * T + ((w).q0 - 128) + (t) * 64 + sc16 * 8)
#define WA_QG(w) (QO + (size_t)((w).q0 + wj * 32 + r32) * D + (w).hq * 64)
    if (vcu >= NU) return;
    WaUnit w = wa_unit(vcu, wid);
    u32x4 stk = *(const u32x4*)WA_KG(w, w.t_lo), stv = *(const u32x4*)WA_VG(w, w.t_lo);
    bf16x8 qf[4];
#pragma unroll
    for (int ds = 0; ds < 4; ++ds) qf[ds] = *(const bf16x8*)(WA_QG(w) + ds * 16 + hi * 8);
    for (int u = vcu; u < NU; u += G) {
        *(LAS u32x4*)(lds + (w.t_lo & 1) * WA_TB + soff) = stk; *(LAS u32x4*)(lds + (2 + (w.t_lo & 1)) * WA_TB + soff) = stv;
        WG_BAR_LDS();
        const bool has_next = (u + G < NU);
        WaUnit wn = w; if (has_next) wn = wa_unit(u + G, wid);
        bf16x8 qn[4];
#pragma unroll
        for (int ds = 0; ds < 4; ++ds) qn[ds] = qf[ds];
        float mrun = 0.f, l = 0.f;
        f32x16 o[2];
#pragma unroll
        for (int db = 0; db < 2; ++db)
#pragma unroll
            for (int r = 0; r < 16; ++r) o[db][r] = 0.f;
        const int t_first = w.t_lo > tw_lo ? w.t_lo : tw_lo;
#pragma unroll 1
        for (int t = w.t_lo; t <= w.t_hi; ++t) {
            if (t < w.t_hi) { stk = *(const u32x4*)WA_KG(w, t + 1); stv = *(const u32x4*)WA_VG(w, t + 1); }
            else if (has_next) { stk = *(const u32x4*)WA_KG(wn, wn.t_lo); stv = *(const u32x4*)WA_VG(wn, wn.t_lo);
#pragma unroll
                for (int ds = 0; ds < 4; ++ds) qn[ds] = *(const bf16x8*)(WA_QG(wn) + ds * 16 + hi * 8); }
            if (t >= tw_lo && t <= tw_hi) {
                const LAS unsigned char* kb_base = lds + (t & 1) * WA_TB + koff;
                const LAS unsigned char* vb_base = lds + (2 + (t & 1)) * WA_TB + voff;
                f32x16 s[2];
                const float negm = -mrun;
#pragma unroll
                for (int kb = 0; kb < 2; ++kb)
#pragma unroll
                    for (int r = 0; r < 16; ++r) s[kb][r] = negm;
                bf16x8 kf[8], vf[8];
#pragma unroll
                for (int j = 0; j < 8; ++j) kf[j] = *(const LAS bf16x8*)(kb_base + (j & 1) * 32 * WA_P + (j >> 1) * 32);
#pragma unroll
                for (int j = 0; j < 8; ++j) vf[j] = *(const LAS bf16x8*)(vb_base + (j & 1) * 32 * WA_P + (j >> 1) * 32);
                __builtin_amdgcn_sched_barrier(0);
#pragma unroll
                for (int j = 0; j < 8; ++j) s[j & 1] = MFMA32(kf[j], qf[j >> 1], s[j & 1]);
                __builtin_amdgcn_sched_barrier(0);
                const bool full = (64 * t >= wj * 32 + 31) && (64 * t + 63 <= wj * 32 + 256);
                if (!full) {
                    const int kap0 = 64 * t + 8 * hi - qrel;
                    if (64 * t < wj * 32 + 31) {
#pragma unroll
                        for (int kb = 0; kb < 2; ++kb)
#pragma unroll
                            for (int r = 0; r < 16; ++r) { const int c = 32 * kb + 16 * (r >> 3) + (r & 7); if (kap0 < -c) s[kb][r] = -1e30f; }
                    } else {
#pragma unroll
                        for (int kb = 0; kb < 2; ++kb)
#pragma unroll
                            for (int r = 0; r < 16; ++r) { const int c = 32 * kb + 16 * (r >> 3) + (r & 7); if (kap0 > 256 - c) s[kb][r] = -1e30f; }
                    }
                }
                float mx = __builtin_fmaxf(vmax16(s[0]), vmax16(s[1]));
                mx = __builtin_fmaxf(mx, __shfl_xor(mx, 32));
                const bool first = (t == t_first);
                if (first || __any(mx > 8.0f)) {
                    const float dl = first ? mx : __builtin_fmaxf(mx, 0.f);
                    mrun += dl;
#pragma unroll
                    for (int kb = 0; kb < 2; ++kb)
#pragma unroll
                        for (int r = 0; r < 16; ++r) s[kb][r] -= dl;
                    if (!first) {
                        const float alpha = __builtin_amdgcn_exp2f(-dl);
                        l *= alpha;
#pragma unroll
                        for (int db = 0; db < 2; ++db)
#pragma unroll
                            for (int r = 0; r < 16; ++r) o[db][r] *= alpha;
                    }
                }
                float ls = 0.f;
#pragma unroll
                for (int kb = 0; kb < 2; ++kb)
#pragma unroll
                    for (int r = 0; r < 16; ++r) { const float p = __builtin_amdgcn_exp2f(s[kb][r]); s[kb][r] = p; ls += p; }
                l += ls;
                bf16x8 pf[4];
                pf[0] = pack8(s[0], 0); pf[1] = pack8(s[0], 1); pf[2] = pack8(s[1], 0); pf[3] = pack8(s[1], 1);
                __builtin_amdgcn_s_setprio(0);
#pragma unroll
                for (int j = 0; j < 8; ++j) o[j & 1] = MFMA32(vf[j], pf[j >> 1], o[j & 1]);
            }
            if (t < w.t_hi) { *(LAS u32x4*)(lds + ((t + 1) & 1) * WA_TB + soff) = stk; *(LAS u32x4*)(lds + (2 + ((t + 1) & 1)) * WA_TB + soff) = stv; }
            WG_BAR_LDS();
        }
        l += __shfl_xor(l, 32);
        l += __builtin_amdgcn_exp2f(sinks[w.hq] * LOG2E - mrun);
        const float inv = 1.0f / l;
        bf16_t* Qg = WA_QG(w);
#pragma unroll
        for (int db = 0; db < 2; ++db)
#pragma unroll
            for (int gq = 0; gq < 4; ++gq) {
                u32x2 ww; ww.x = pk_bf16(o[db][4 * gq] * inv, o[db][4 * gq + 1] * inv); ww.y = pk_bf16(o[db][4 * gq + 2] * inv, o[db][4 * gq + 3] * inv);
                *(u32x2*)(Qg + db * 32 + gq * 8 + hi * 4) = ww;
            }
        w = wn;
#pragma unroll
        for (int ds = 0; ds < 4; ++ds) qf[ds] = qn[ds];
    }
#undef WA_KG
#undef WA_VG
#undef WA_QG
}

__device__ __forceinline__ unsigned f2bf(float f) { return pk_bf16(f, 0.f) & 0xffffu; }
__device__ __forceinline__ void p0_transpose_item(const float* W, int K, int N, bf16_t* WT, const float* gain, int permlim, LAS float* scr, int item, int lane) {
    const int nblk = N / 32, kb = item / nblk, nb = item % nblk, k0 = 64 * kb, n0 = 32 * nb;
    const float* src = W + (size_t)(k0 + (lane >> 5)) * N + n0 + (lane & 31);
    float v[32];
#pragma unroll
    for (int i = 0; i < 32; ++i) v[i] = src[(size_t)(2 * i) * N];
    const int c = lane & 7;
    f32x4 g0 = (f32x4){1.f, 1.f, 1.f, 1.f}, g1 = g0;
    if (gain) { g0 = *(const f32x4*)(gain + k0 + 8 * c); g1 = *(const f32x4*)(gain + k0 + 8 * c + 4); }
#pragma unroll
    for (int i = 0; i < 32; ++i) scr[(2 * i + (lane >> 5)) * 33 + (lane & 31)] = v[i];
    asm volatile("s_waitcnt lgkmcnt(0)" ::: "memory");
#pragma unroll
    for (int j = 0; j < 4; ++j) { const int n = (lane >> 3) + 8 * j; const LAS float* s = scr + (8 * c) * 33 + n;
        u32x4 o; o.x = pk_bf16(s[0 * 33] * g0[0], s[1 * 33] * g0[1]); o.y = pk_bf16(s[2 * 33] * g0[2], s[3 * 33] * g0[3]); o.z = pk_bf16(s[4 * 33] * g1[0], s[5 * 33] * g1[1]); o.w = pk_bf16(s[6 * 33] * g1[2], s[7 * 33] * g1[3]);
        int nn = n0 + n;
        if (nn < permlim) { const int d = nn & 63; const int p = (d < 32) ? (8 * (d >> 2) + (d & 3)) : (8 * ((d - 32) >> 2) + 4 + (d & 3)); nn = (nn & ~63) | p; }
        *(u32x4*)(WT + (size_t)nn * K + k0 + 8 * c) = o; }
    asm volatile("s_waitcnt lgkmcnt(0)" ::: "memory");
}

struct Args { const float* in[19]; float* out; unsigned char* ws; int lo, hi; };
typedef const __attribute__((address_space(4))) unsigned char* karg_t;
typedef const float* cfptr_t;
#define KIN(i) (*(const __attribute__((address_space(4))) cfptr_t*)(kp + 8 * (i)))
#define KOUT (*(float* const __attribute__((address_space(4)))*)(kp + 152))
#define KWS (*(unsigned char* const __attribute__((address_space(4)))*)(kp + 160))

constexpr size_t WS_QCTR = 8192;
__device__ __forceinline__ void prologue_phase(karg_t kp, LAS unsigned char* lds, int vcu, int G) {
    int tid_ = threadIdx.x; asm volatile("" : "+v"(tid_));
    const int tid = tid_, lane = tid & 63, wave = __builtin_amdgcn_readfirstlane(tid >> 6);
    unsigned char* ws = KWS;
    LAS float* scr = (LAS float*)(lds + wave * 16384);
    const int gw = vcu * NWAVES + wave, NGW = G * NWAVES;
#if PROBE
    if (blockIdx.x == 0 && tid == 0) ((unsigned long long*)ws)[100] = __builtin_amdgcn_s_memrealtime();
#endif
    for (int m = gw; m < NMEMROWS; m += NGW) {
        const float* src = (m < 4096) ? KIN(2) + (size_t)m * D : KIN(3) + (size_t)(m - 4096) * D;
        f32x4 v[4]; float s = 0.f;
#pragma unroll
        for (int j = 0; j < 4; ++j) { v[j] = *((const f32x4*)src + lane + 64 * j); s += (v[j][0] * v[j][0] + v[j][1] * v[j][1]) + (v[j][2] * v[j][2] + v[j][3] * v[j][3]); }
        s = wave_sum(s);
        u32x2* o8 = (u32x2*)((bf16_t*)(ws + WS_MB) + (size_t)m * D) + lane;
#pragma unroll
        for (int j = 0; j < 4; ++j) { u32x2 w; w.x = pk_bf16(v[j][0], v[j][1]); w.y = pk_bf16(v[j][2], v[j][3]); o8[64 * j] = w; }
        if (lane < 4) ((float*)(ws + WS_SSPM))[(size_t)m * 4 + lane] = (lane == 0) ? s : 0.f;
    }
    { float* rc = (float*)(ws + WS_ROPE); float* rsn = rc + SEQS * 32;
      for (int idx = (vcu * NTHR + tid); idx < SEQS * 32; idx += G * NTHR) {
          const int pos = idx >> 5, i = idx & 31;
          const float invf = exp2f(-(float)(2 * i) * (13.287712379549449f / 64.0f));
          const float ang = (float)pos * invf;
          const double rev = (double)ang * 0.15915494309189535; const float fr = (float)(rev - floor(rev));
          rc[idx] = __builtin_amdgcn_cosf(fr); rsn[idx] = __builtin_amdgcn_sinf(fr); } }
#if PROBE
    if (blockIdx.x == 0 && tid == 0) ((unsigned long long*)ws)[101] = __builtin_amdgcn_s_memrealtime();
#endif
    constexpr int I_PW = 4 * 8, I_QKV = 16 * 48, I_DD = 16 * 32, I_KV = 16 * 64, I_UP = 16 * 128, I_DN = 64 * 32;
    constexpr int NITEMS = 4 * I_PW + I_QKV + I_DD + 2 * I_DD + 2 * I_KV + 2 * I_DD + 2 * I_UP + 2 * I_DN;
    for (int it = gw; it < NITEMS; it += NGW) {
        int r = it;
        if (r < 2 * I_UP) { const int L = r / I_UP; p0_transpose_item(KIN(16) + (size_t)L * D * FF, D, FF, (bf16_t*)(ws + WS_WUP) + (size_t)L * D * FF, KIN(15) + L * D, 0, scr, r % I_UP, lane); continue; } r -= 2 * I_UP;
        if (r < 2 * I_DN) { const int L = r / I_DN; p0_transpose_item(KIN(17) + (size_t)L * D * FF, FF, D, (bf16_t*)(ws + WS_WDN) + (size_t)L * D * FF, nullptr, 0, scr, r % I_DN, lane); continue; } r -= 2 * I_DN;
        if (r < 2 * I_KV) { const int L = r / I_KV; p0_transpose_item(KIN(13) + (size_t)L * D * 2 * D, D, 2 * D, (bf16_t*)(ws + WS_WXKV) + (size_t)L * D * 2 * D, KIN(11) + L * D, 0, scr, r % I_KV, lane); continue; } r -= 2 * I_KV;
        if (r < I_QKV) { p0_transpose_item(KIN(7), D, NQKV, (bf16_t*)(ws + WS_WQKV), KIN(4) + D, 1280, scr, r, lane); continue; } r -= I_QKV;
        if (r < I_DD) { p0_transpose_item(KIN(8), D, D, (bf16_t*)(ws + WS_WAO), nullptr, 0, scr, r, lane); continue; } r -= I_DD;
        if (r < 2 * I_DD) { const int L = r / I_DD; p0_transpose_item(KIN(12) + (size_t)L * D * D, D, D, (bf16_t*)(ws + WS_WXQ) + (size_t)L * D * D, KIN(10) + L * D, 0, scr, r % I_DD, lane); continue; } r -= 2 * I_DD;
        if (r < 2 * I_DD) { const int L = r / I_DD; p0_transpose_item(KIN(14) + (size_t)L * D * D, D, D, (bf16_t*)(ws + WS_WXO) + (size_t)L * D * D, nullptr, 0, scr, r % I_DD, lane); continue; } r -= 2 * I_DD;
        { const int gI = r / I_PW; p0_transpose_item(KIN(5) + (size_t)gI * 65536, 256, 256, (bf16_t*)(ws + WS_PW) + (size_t)gI * 65536, nullptr, 0, scr, r % I_PW, lane); }
    }
}

__device__ __forceinline__ void pool_phase(karg_t kp, LAS unsigned char* lds, int vcu, int G) {
    int tid_ = threadIdx.x; asm volatile("" : "+v"(tid_));
    const int tid = tid_, lane = tid & 63, wave = __builtin_amdgcn_readfirstlane(tid >> 6);
    bf16_t* diff = (bf16_t*)(KWS + WS_QB);
    const float* x0 = KIN(0); const float* x1 = KIN(1); const float* gmix = KIN(4);
    constexpr int NU = T / 32;
    f32x4 gm[4];
#pragma unroll
    for (int j = 0; j < 4; ++j) gm[j] = *((const f32x4*)gmix + lane + 64 * j);
    f32x4 pv[6][4];
#define POOL_FETCH(u) do { const int t0_ = (u) * 32; \
        const int s0_ = t0_ < TP ? (t0_ & ~(SEQP - 1)) : (t0_ & ~(SEQS - 1)), s1_ = s0_ + (t0_ < TP ? SEQP : SEQS); \
        _Pragma("unroll") for (int q = 0; q < 6; ++q) { const int grow = t0_ - 8 + wave * 6 + q; \
            if (grow >= s0_ && grow < s1_) { const float* src = (grow < TP) ? x0 + (size_t)grow * D : x1 + (size_t)(grow - TP) * D; \
                _Pragma("unroll") for (int j = 0; j < 4; ++j) pv[q][j] = *((const f32x4*)src + lane + 64 * j); } \
            else { _Pragma("unroll") for (int j = 0; j < 4; ++j) pv[q][j] = (f32x4){0.f, 0.f, 0.f, 0.f}; } } } while (0)
    if (vcu < NU) POOL_FETCH(vcu);
    __syncthreads();
    for (int u = vcu; u < NU; u += G) {
        const int t0 = u * 32;
        const int s0 = t0 < TP ? (t0 & ~(SEQP - 1)) : (t0 & ~(SEQS - 1)), s1 = s0 + (t0 < TP ? SEQP : SEQS);
#pragma unroll
        for (int q = 0; q < 6; ++q) {
            float ss = 0.f;
#pragma unroll
            for (int j = 0; j < 4; ++j) ss += (pv[q][j][0] * pv[q][j][0] + pv[q][j][1] * pv[q][j][1]) + (pv[q][j][2] * pv[q][j][2] + pv[q][j][3] * pv[q][j][3]);
            const float rs = rsqrtf(wave_sum(ss) * (1.0f / D) + EPS);
#pragma unroll
            for (int j = 0; j < 4; ++j) { const f32x4 h = pv[q][j] * rs * gm[j]; u32x2 w; w.x = pk_bf16(h[0], h[1]); w.y = pk_bf16(h[2], h[3]);
                *(LAS u32x2*)(lds + (wave * 6 + q) * 2048 + (lane + 64 * j) * 8) = w; }
        }
        WG_BAR_LDS();
        if (u + G < NU) POOL_FETCH(u + G);
        const int c2 = tid * 2, g = tid >> 7, hw = 1 << g;
        const LAS unsigned char* col = lds + c2 * 2;
#define POOL_LD(r) ({ const unsigned w_ = *(const LAS unsigned*)(col + (r) * 2048); (f32x2){__uint_as_float(w_ << 16), __uint_as_float(w_ & 0xffff0000u)}; })
        f32x2 sum = (f32x2){0.f, 0.f};
        for (int j = -hw; j < hw; ++j) sum += POOL_LD(8 + j);
        for (int r = 0; r < 32; ++r) {
            const int t = t0 + r;
            const int lo = max(t - hw, s0), hi2 = min(t + hw, s1);
            const f32x2 ctr = POOL_LD(r + 8);
            const float ic = 1.0f / (float)(hi2 - lo);
            *(unsigned*)(diff + (size_t)t * D + c2) = pk_bf16(sum[0] * ic - ctr[0], sum[1] * ic - ctr[1]);
            if (r < 31) sum += POOL_LD(r + 8 + hw) - POOL_LD(r + 8 - hw);
        }
        WG_BAR_LDS();
    }
#undef POOL_FETCH
#undef POOL_LD
}

__device__ __forceinline__ void final_phase(karg_t kp, int vcu, int G) {
    int tid_ = threadIdx.x; asm volatile("" : "+v"(tid_));
    const int tid = tid_, lane = tid & 63, wave = __builtin_amdgcn_readfirstlane(tid >> 6);
    const int gw = vcu * NWAVES + wave, NGW = G * NWAVES;
    const bf16_t* XB = (const bf16_t*)(KWS + WS_XB);
    f32x4 gn[4];
#pragma unroll
    for (int j = 0; j < 4; ++j) gn[j] = *((const f32x4*)KIN(18) + lane + 64 * j);
    for (int m = gw; m < T; m += 2 * NGW) {
        u32x2 w[2][4];
#pragma unroll
        for (int q = 0; q < 2; ++q)
#pragma unroll
            for (int j = 0; j < 4; ++j) w[q][j] = *((const u32x2*)(XB + (size_t)(m + q * NGW) * D) + lane + 64 * j);
#pragma unroll
        for (int q = 0; q < 2; ++q) {
            f32x4 v[4]; float s = 0.f;
#pragma unroll
            for (int j = 0; j < 4; ++j) {
                v[j] = (f32x4){__uint_as_float(w[q][j].x << 16), __uint_as_float(w[q][j].x & 0xffff0000u), __uint_as_float(w[q][j].y << 16), __uint_as_float(w[q][j].y & 0xffff0000u)};
                s += (v[j][0] * v[j][0] + v[j][1] * v[j][1]) + (v[j][2] * v[j][2] + v[j][3] * v[j][3]);
            }
            const float rs = rsqrtf(wave_sum(s) * (1.0f / D) + EPS);
            f32x4* row = (f32x4*)(KOUT + (size_t)(m + q * NGW) * D);
#pragma unroll
            for (int j = 0; j < 4; ++j) __builtin_nontemporal_store(v[j] * rs * gn[j], row + lane + 64 * j);
        }
    }
}

#define XB_TMO      128
#define XB_XCNT(j)  (256  + 64 * (j))
#define XB_XSUB(j)  (1280 + 64 * (j))
#define XB_XGEN(j)  (2304 + 64 * (j))
#define XB_TOP      3328
#define XB_TOPGEN   3392
#define XCD_BAR_WORDS 3456
#define XB_SPIN_CAP (1u << 22)
__device__ __forceinline__ unsigned xb_ld(unsigned* p)              { return __hip_atomic_load(p, __ATOMIC_RELAXED, __HIP_MEMORY_SCOPE_AGENT); }
__device__ __forceinline__ unsigned xb_add(unsigned* p, unsigned v) { return __hip_atomic_fetch_add(p, v, __ATOMIC_RELAXED, __HIP_MEMORY_SCOPE_AGENT); }
__device__ __forceinline__ unsigned xb_xcc_id() { return (unsigned)__builtin_amdgcn_s_getreg((3 << 11) | 20) & 0xFu; }
#define XB_SPIN(cond, bar) do { unsigned _sp = 0; while (cond) { __builtin_amdgcn_s_sleep(1); \
    if ((++_sp & 255u) == 0u) { if (xb_ld(&(bar)[XB_TMO])) break; if (_sp > XB_SPIN_CAP) { atomicAdd(&(bar)[XB_TMO], 1u); break; } } } } while (0)
struct XcdBarrier { unsigned* bar; unsigned x; volatile LAS unsigned* st; };
__device__ __forceinline__ XcdBarrier xcd_barrier_post(unsigned* bar, volatile LAS unsigned* st) {
    XcdBarrier b; b.bar = bar; b.x = xb_xcc_id(); b.st = st;
    if (threadIdx.x == 0) (void)xb_add(&bar[XB_XCNT(b.x)], 1u);
    return b;
}
__device__ __forceinline__ void xcd_barrier_complete(unsigned* bar, unsigned x, unsigned& nloc, unsigned& nx) {
    const unsigned G = gridDim.x * gridDim.y * gridDim.z;
    unsigned sum, cnt, mine, sp = 0u;
    for (;;) {
        sum = 0u; cnt = 0u; mine = 0u;
#pragma unroll
        for (unsigned j = 0; j < 16; ++j) { const unsigned c = xb_ld(&bar[XB_XCNT(j)]); sum += c; cnt += (c > 0u) ? 1u : 0u; mine = (j == x) ? c : mine; }
        if (sum == G) break;
        __builtin_amdgcn_s_sleep(1);
        if ((++sp & 255u) == 0u) { if (xb_ld(&bar[XB_TMO])) break; if (sp > XB_SPIN_CAP) { atomicAdd(&bar[XB_TMO], 1u); break; } }
    }
    nloc = mine > 0u ? mine : 1u; nx = cnt > 0u ? cnt : 1u;
}
__device__ __forceinline__ void xcd_barrier(const XcdBarrier& b) {
    asm volatile("s_waitcnt vmcnt(0)" ::: "memory");
    __syncthreads();
    if (threadIdx.x == 0) {
        unsigned* bar = b.bar;
        __builtin_amdgcn_s_waitcnt(0);
        unsigned nloc = b.st[0], nx = b.st[1];
        if (nloc == 0u) { xcd_barrier_complete(bar, b.x, nloc, nx); b.st[0] = nloc; b.st[1] = nx; }
        const unsigned old = xb_add(&bar[XB_XSUB(b.x)], 1u);
        const unsigned gen = old / nloc;
        if (old + 1u == (gen + 1u) * nloc) {
            __builtin_amdgcn_fence(__ATOMIC_RELEASE, "agent");
            asm volatile("s_waitcnt vmcnt(0)" ::: "memory");
            const unsigned og = xb_add(&bar[XB_TOP], 1u);
            const unsigned tg = og / nx;
            if (og + 1u == (tg + 1u) * nx) xb_add(&bar[XB_TOPGEN], 1u);
            else XB_SPIN(xb_ld(&bar[XB_TOPGEN]) == tg, bar);
            __builtin_amdgcn_fence(__ATOMIC_ACQUIRE, "agent");
            xb_add(&bar[XB_XGEN(b.x)], 1u);
            asm volatile("s_waitcnt vmcnt(0)" ::: "memory");
        } else {
            XB_SPIN(xb_ld(&bar[XB_XGEN(b.x)]) == gen, bar);
            __builtin_amdgcn_fence(__ATOMIC_ACQUIRE, "agent");
            asm volatile("s_waitcnt vmcnt(0)" ::: "memory");
        }
    }
    __syncthreads();
}
constexpr size_t WS_BAR = 16384;
constexpr int LDS_MISC = 131072 + 1024, LDS_RED = 131072 + 4096;

enum { K_PRO = 0, K_POOL, K_G_RESID, K_G_ROW, K_G_UP, K_G_QKV, K_XATT, K_WATT, K_FINAL };
constexpr int NSTEPS = 28;
struct Step {
    int kind, sync;
    pg8::Gemm g;
    const float* base_lo; const float* base_hi; int split_row; int base_f32; const float* cscale;
    bf16_t* out; int ldc; const float* ssp; float cst; int tsplit; bf16_t* vt; int t_pm_stride, t_ld;
    int layer;
};

__device__ __forceinline__ Step make_step(int vs, karg_t kp) {
    unsigned char* ws = KWS;
    const bool partB = (vs == 15); const int st = partB ? 4 : (vs < 15 ? vs : vs - 1);
    Step s; s.kind = K_PRO; s.sync = 1; s.g = pg8::Gemm{nullptr, nullptr, D, D, D, 0, 0, 0, 0};
    s.base_lo = nullptr; s.base_hi = nullptr; s.split_row = 1 << 30; s.base_f32 = 0; s.cscale = nullptr;
    s.out = nullptr; s.ldc = D; s.ssp = (const float*)(ws + WS_SSP); s.cst = 1.f; s.tsplit = 1 << 20; s.vt = nullptr; s.t_pm_stride = 0; s.t_ld = 0; s.layer = 0;
    bf16_t* XB = (bf16_t*)(ws + WS_XB); bf16_t* QB = (bf16_t*)(ws + WS_QB);
    int mlp = -1, xa = -1;
    if (st == 0) { s.kind = K_PRO; s.sync = 0; }
    else if (st == 1) { s.kind = K_POOL; }
    else if (st == 2) { s.kind = K_G_RESID; s.sync = 0; s.g = pg8::Gemm{QB, (const bf16_t*)(ws + WS_PW), D, 256, 256, 256, T / 256, 4, 0};
        s.base_lo = KIN(0); s.base_hi = KIN(1); s.split_row = TP; s.base_f32 = 1; s.cscale = KIN(6); }
    else if (st == 3 || st == 4) { const int L = st - 3; s.kind = K_G_ROW; s.sync = (st == 4); s.layer = L;
        s.g = pg8::Gemm{(const bf16_t*)(ws + WS_MB), (const bf16_t*)(ws + WS_WXKV) + (size_t)L * 2 * D * D, D, D, D, 0, NMEMROWS / 256, 8, 0};
        s.out = (bf16_t*)(ws + WS_KM) + (size_t)L * NMEMROWS * D; s.ldc = D; s.ssp = (const float*)(ws + WS_SSPM); s.cst = 1.f; s.tsplit = 4;
        s.vt = (bf16_t*)(ws + WS_VMT) + (size_t)L * NMEMROWS * D; s.t_pm_stride = D * 256; s.t_ld = 256;
        if (L == 1) { if (partB) { s.g.u_lo = 0; s.g.u_cnt = 128; s.g.c_rot = 128; s.sync = 1; } else { s.g.u_lo = 128; s.g.u_cnt = 16; s.g.c_rot = 144; } } }
    else if (st >= 5 && st <= 7) { xa = st - 5; s.layer = 0; }
    else if (st >= 8 && st <= 13) { mlp = st - 8; s.layer = 0; }
    else if (st == 14) { s.kind = K_G_QKV; s.sync = 0; s.g = pg8::Gemm{XB, (const bf16_t*)(ws + WS_WQKV), D, D, D, 0, T / 256, 6, 0}; }
    else if (st == 15) { s.kind = K_WATT; }
    else if (st == 16) { s.kind = K_G_RESID; s.g = pg8::Gemm{QB, (const bf16_t*)(ws + WS_WAO), D, D, D, 0, T / 256, 4, 0}; }
    else if (st >= 17 && st <= 19) { xa = st - 17; s.layer = 1; }
    else if (st >= 20 && st <= 25) { mlp = st - 20; s.layer = 1; }
    else { s.kind = K_FINAL; s.sync = 0; }
    if (xa == 0) { s.kind = K_G_ROW; s.g = pg8::Gemm{XB, (const bf16_t*)(ws + WS_WXQ) + (size_t)s.layer * D * D, D, D, D, 0, T / 256, 4, 0};
        s.out = QB; s.ldc = D; s.cst = 0.0625f * LOG2E; s.sync = 0; }
    else if (xa == 1) { s.kind = K_XATT; }
    else if (xa == 2) { s.kind = K_G_RESID; s.g = pg8::Gemm{QB, (const bf16_t*)(ws + WS_WXO) + (size_t)s.layer * D * D, D, D, D, 0, T / 256, 4, 0}; }
    if (mlp >= 0) {
        const int c = mlp >> 1, pm0 = 64 * c;
        bf16_t* H = (bf16_t*)(ws + ((c & 1) ? WS_H1 : WS_H0)) - (size_t)pm0 * 256 * FF;
        if ((mlp & 1) == 0) { s.kind = K_G_UP; s.sync = 1; s.g = pg8::Gemm{XB, (const bf16_t*)(ws + WS_WUP) + (size_t)s.layer * D * FF, D, D, D, 0, 64, 16, pm0}; s.out = H; }
        else { s.kind = K_G_RESID; s.sync = (c == 2); s.g = pg8::Gemm{H, (const bf16_t*)(ws + WS_WDN) + (size_t)s.layer * D * FF, FF, FF, FF, 0, 64, 4, pm0}; }
    }
    return s;
}

__global__ void __launch_bounds__(NTHR, 2) fwd_megakernel(Args a) {
    __builtin_assume(__builtin_amdgcn_workitem_id_y() == 0); __builtin_assume(__builtin_amdgcn_workitem_id_z() == 0);
    extern __shared__ __attribute__((aligned(16))) unsigned char lds_raw[];
    LAS unsigned char* lds = (LAS unsigned char*)lds_raw;
    karg_t kp = (karg_t)__builtin_amdgcn_kernarg_segment_ptr();
    const int G = gridDim.x, bx = blockIdx.x;
    const int vcu = (G % 8 == 0) ? (bx % 8) * (G / 8) + bx / 8 : bx;
    unsigned char* ws = KWS;
    volatile LAS unsigned* misc = (volatile LAS unsigned*)(lds + LDS_MISC);
    if (threadIdx.x < 2) misc[threadIdx.x] = 0u;
    __syncthreads();
    XcdBarrier bar = xcd_barrier_post((unsigned*)(ws + WS_BAR), misc);
#if PROBE
    unsigned long long* tsb = (unsigned long long*)ws;
#endif
    for (int st = a.lo; st < a.hi; ++st) {
        asm volatile("" : "+s"(kp));
        const Step s = make_step(st, kp);
#if PROBE
        if (bx == 0 && threadIdx.x == 0) tsb[2 * st] = __builtin_amdgcn_s_memrealtime();
#endif
        switch (s.kind) {
        case K_PRO: prologue_phase(kp, lds, vcu, G); break;
        case K_POOL: pool_phase(kp, lds, vcu, G); break;
        case K_G_RESID: { pg8::EpiResid E{s.base_lo, s.base_hi, s.split_row, s.base_f32, (bf16_t*)(ws + WS_XB), (float*)(ws + WS_SSP), s.cscale, (LAS float*)(lds + LDS_RED)};
            pg8::gemm_phase<pg8::EpiResid>(lds, s.g, G, bx, E); } break;
        case K_G_ROW: { pg8::EpiRowScale E{s.out, s.ldc, s.ssp, s.cst, s.tsplit, s.vt, s.t_pm_stride, s.t_ld};
            pg8::gemm_phase<pg8::EpiRowScale>(lds, s.g, G, bx, E); } break;
        case K_G_UP: { pg8::EpiUp E{s.out, s.ssp};
            pg8::gemm_phase<pg8::EpiUp>(lds, s.g, G, bx, E); } break;
        case K_G_QKV: { pg8::EpiQKV E{(bf16_t*)(ws + WS_QB), (bf16_t*)(ws + WS_KW), (bf16_t*)(ws + WS_VT), (const float*)(ws + WS_SSP), (const float*)(ws + WS_ROPE), (const float*)(ws + WS_ROPE) + SEQS * 32};
            pg8::gemm_phase<pg8::EpiQKV>(lds, s.g, G, bx, E); } break;
        case K_XATT: {
            const bf16_t* KM = (const bf16_t*)(ws + WS_KM) + (size_t)s.layer * NMEMROWS * D; const bf16_t* VMT = (const bf16_t*)(ws + WS_VMT) + (size_t)s.layer * NMEMROWS * D;
            __builtin_amdgcn_fence(__ATOMIC_ACQUIRE, "agent");
            pg8::Gemm gq{nullptr, nullptr, D, D, D, 0, T / 256, 4, 0};
            pg8::Order S; S.init(gq, G, bx);
            pg8::Unit u;
            for (int i = 0; S.next(i, u); ++i) xattn_unit(lds, (bf16_t*)(ws + WS_QB), KM, VMT, u.pm, u.pn);
        } break;
        case K_WATT: {
            wattn_phase(lds, (bf16_t*)(ws + WS_QB), (const bf16_t*)(ws + WS_KW), (const bf16_t*)(ws + WS_VT), KIN(9), vcu, G);
        } break;
        default: final_phase(kp, vcu, G); break;
        }
#if PROBE
        __syncthreads();
        if (bx == 0 && threadIdx.x == 0) tsb[2 * st + 1] = __builtin_amdgcn_s_memrealtime();
#endif
        if (s.sync && st + 1 < a.hi) { if (a.hi < 0) cg::this_grid().sync(); else xcd_barrier(bar); }
    }
#if PROBE
    cg::this_grid().sync();
    if (bx == 0 && threadIdx.x == 0) {
        const unsigned long long tend = __builtin_amdgcn_s_memrealtime();
        unsigned long long sa = 0, sa2 = 0, sb = 0;
        for (int st = 0; st < NSTEPS; ++st) {
            const unsigned long long w = tsb[2 * st + 1] - tsb[2 * st], y = (st + 1 < NSTEPS ? tsb[2 * st + 2] : tend) - tsb[2 * st + 1];
            if ((P_A1W >> st) & 1ull) sa += w; if ((P_A2W >> st) & 1ull) sa2 += w; if ((P_A1S >> st) & 1ull) sa += y; if ((P_A2S >> st) & 1ull) sa2 += y;
            if ((P_BW >> st) & 1ull) sb += w; if ((P_BS >> st) & 1ull) sb += y;
        }
#if PROBE_SET == 9
        sa = tsb[100] - tsb[0]; sa2 = tsb[101] - tsb[100];
#endif
#if PROBE_SET == 13
        sa = tsb[2 * (NSTEPS - 1) + 1] - tsb[0]; sa2 = 0;
#endif
        const float ta = (float)sa * 0.01f, ta2 = (float)sa2 * 0.01f;
        KOUT[0] += sqrtf(ta * 2.5e-8f * 33554432.f); KOUT[(size_t)TP * D] += sqrtf(ta * 2.5e-8f * 16777216.f);
        KOUT[1] += sqrtf(ta2 * 2.5e-8f * 33554432.f); KOUT[(size_t)TP * D + 1] += sqrtf(ta2 * 2.5e-8f * 16777216.f);
        const unsigned long long t0 = __builtin_amdgcn_s_memrealtime();
        while (__builtin_amdgcn_s_memrealtime() - t0 < sb) __builtin_amdgcn_s_sleep(8);
    }
#endif
}

constexpr int LDS_BYTES = 147456;
extern "C" void kernel_launch(void* const* d_in, const int* in_sizes, int n_in, void* d_out, int out_size, void* d_ws, size_t ws_size, hipStream_t stream) {
    static int grid = 0;
    if (grid == 0) {
        if (n_in != 19 || out_size != T * D || ws_size < WS_END) { fprintf(stderr, "kernel_launch: unexpected problem (n_in %d, out %d, ws %zu); nothing launched\n", n_in, out_size, ws_size); grid = -1; return; }
        int dev = 0, cus = 0, per_cu = 0;
        hipGetDevice(&dev); hipDeviceGetAttribute(&cus, hipDeviceAttributeMultiprocessorCount, dev);
        if (hipFuncSetAttribute((const void*)fwd_megakernel, hipFuncAttributeMaxDynamicSharedMemorySize, LDS_BYTES) != hipSuccess) { fprintf(stderr, "kernel_launch: hipFuncSetAttribute failed\n"); grid = -1; return; }
        if (hipOccupancyMaxActiveBlocksPerMultiprocessor(&per_cu, (const void*)fwd_megakernel, NTHR, LDS_BYTES) != hipSuccess || per_cu < 1) { fprintf(stderr, "kernel_launch: occupancy query says %d\n", per_cu); per_cu = 1; }
        (void)hipGetLastError();
        grid = cus * per_cu;
        fprintf(stderr, "kernel_launch: grid %d (%d CUs x %d)\n", grid, cus, per_cu);
    }
    if (grid < 0) return;
    if (hipMemsetAsync(d_ws, 0, 65536, stream) != hipSuccess) { fprintf(stderr, "kernel_launch: memset failed\n"); return; }
    Args a{};
    for (int i = 0; i < 19; ++i) a.in[i] = (const float*)d_in[i];
    a.out = (float*)d_out; a.ws = (unsigned char*)d_ws;
#if ONE_LAUNCH
    a.lo = 0; a.hi = NSTEPS;
    void* args[] = {&a};
    hipError_t e = hipLaunchCooperativeKernel((const void*)fwd_megakernel, dim3(grid), dim3(NTHR), args, LDS_BYTES, stream);
    if (e != hipSuccess) fprintf(stderr, "kernel_launch: cooperative launch failed: %s (grid %d)\n", hipGetErrorString(e), grid);
#else
    for (int st = 0; st < NSTEPS; ++st) {
        a.lo = st; a.hi = st + 1;
        hipLaunchKernelGGL(fwd_megakernel, dim3(grid), dim3(NTHR), LDS_BYTES, stream, a);
    }
#endif
}
```

```cpp
#include <hip/hip_runtime.h>
#include <hip/hip_cooperative_groups.h>
#include <cstdio>
#include <cstdint>
namespace cg = cooperative_groups;

#ifndef ONE_LAUNCH
#define ONE_LAUNCH 1
#endif
#ifndef PROBE
#define PROBE 0
#endif
#define M_GEMM ((1ull<<2)|(1ull<<3)|(1ull<<4)|(1ull<<5)|(1ull<<7)|(0x3full<<8)|(1ull<<14)|(1ull<<16)|(1ull<<17)|(1ull<<19)|(0x3full<<20))
#define M_ATT ((1ull<<6)|(1ull<<15)|(1ull<<18))
#define M_ELEM ((1ull<<0)|(1ull<<1)|(1ull<<26))
#define M_ALL ((1ull<<27)-1)
#ifndef PROBE_SET
#define PROBE_SET 1
#endif
#define BIT(i) (1ull << (i))
#if PROBE_SET == 1
#define P_A1W BIT(8)
#define P_A2W BIT(9)
#define P_BW 0ull
#define P_BS M_ALL
#elif PROBE_SET == 2
#define P_A1W BIT(15)
#define P_A2W BIT(6)
#define P_BW BIT(0)
#define P_BS 0ull
#elif PROBE_SET == 3
#define P_A1W BIT(7)
#define P_A2W BIT(5)
#define P_BW BIT(1)
#define P_BS 0ull
#elif PROBE_SET == 4
#define P_A1W BIT(14)
#define P_A2W BIT(2)
#define P_BW (BIT(3) | BIT(4))
#define P_BS 0ull
#elif PROBE_SET == 5
#define P_A1W BIT(26)
#define P_A2W BIT(16)
#define P_BW M_GEMM
#define P_BS 0ull
#elif PROBE_SET == 7
#define P_A1W BIT(0)
#define P_A2W 0ull
#define P_A1S 0ull
#define P_A2S BIT(0)
#define P_BW 0ull
#define P_BS BIT(1)
#elif PROBE_SET == 11
#define P_A1W M_GEMM
#define P_A2W 0ull
#define P_A1S 0ull
#define P_A2S M_ALL
#define P_BW M_ATT
#define P_BS 0ull
#elif PROBE_SET == 12
#define P_A1W BIT(0)
#define P_A2W BIT(1)
#define P_BW BIT(26)
#define P_BS 0ull
#elif PROBE_SET == 13
#define P_A1W 0ull
#define P_A2W 0ull
#define P_BW 0ull
#define P_BS 0ull
#elif PROBE_SET == 10
#define P_A1W BIT(9)
#define P_A2W BIT(13)
#define P_BW BIT(8)
#define P_BS 0ull
#elif PROBE_SET == 9
#define P_A1W 0ull
#define P_A2W 0ull
#define P_BW BIT(1)
#define P_BS BIT(1)
#elif PROBE_SET == 8
#define P_A1W BIT(1)
#define P_A2W 0ull
#define P_A1S 0ull
#define P_A2S BIT(4)
#define P_BW 0ull
#define P_BS (BIT(5)|BIT(7)|BIT(14)|BIT(16)|BIT(17)|BIT(19))
#else
#define P_A1W 0ull
#define P_A2W 0ull
#define P_A1S ((0x3full << 8) | (0x3full << 20))
#define P_A2S (BIT(6) | BIT(15) | BIT(18))
#define P_BW 0ull
#define P_BS (BIT(0) | BIT(1) | BIT(4))
#endif
#ifndef P_A1S
#define P_A1S 0ull
#define P_A2S 0ull
#endif

#define LAS __attribute__((address_space(3)))
typedef unsigned short bf16_t;
typedef short bf16x8 __attribute__((ext_vector_type(8)));
typedef float f32x4 __attribute__((ext_vector_type(4)));
typedef float f32x2 __attribute__((ext_vector_type(2)));
typedef float f32x16 __attribute__((ext_vector_type(16)));
typedef unsigned u32x4 __attribute__((ext_vector_type(4)));
typedef unsigned u32x2 __attribute__((ext_vector_type(2)));
typedef __bf16 bf16x2_t __attribute__((ext_vector_type(2)));

constexpr int D = 1024, FF = 4096, T = 49152, TP = 32768, SEQP = 2048, SEQS = 8192, NMEMROWS = 4608, NQKV = 1536;
constexpr float EPS = 1e-6f, LOG2E = 1.4426950408889634f;
constexpr int NWAVES = 8, NTHR = 512;

constexpr size_t MiB = 1u << 20;
constexpr size_t WS_PW = 1 * MiB, WS_WQKV = 2 * MiB, WS_WAO = 5 * MiB, WS_WXQ = 7 * MiB, WS_WXKV = 11 * MiB, WS_WXO = 19 * MiB, WS_WUP = 23 * MiB, WS_WDN = 39 * MiB;
constexpr size_t WS_ROPE = 55 * MiB, WS_RSTD0 = 57 * MiB, WS_SSP = 58 * MiB, WS_SSPM = 61 * MiB, WS_MB = 62 * MiB, WS_KM = 71 * MiB, WS_VMT = 89 * MiB, WS_XB = 108 * MiB;
constexpr size_t WS_BIG = 204 * MiB, WS_QB = WS_BIG, WS_KW = WS_BIG + 96 * MiB, WS_VT = WS_BIG + 120 * MiB, WS_H0 = WS_BIG, WS_H1 = WS_BIG + 128 * MiB, WS_END = WS_BIG + 256 * MiB;

__device__ __forceinline__ unsigned pk_bf16(float lo, float hi) { f32x2 v = {lo, hi}; bf16x2_t b = __builtin_convertvector(v, bf16x2_t); return __builtin_bit_cast(unsigned, b); }
__device__ __forceinline__ float rstd_from(const float* p) {
    const f32x4 s = *(const f32x4*)p;
    return rsqrtf(((s[0] + s[1]) + (s[2] + s[3])) * (1.0f / D) + EPS);
}
__device__ __forceinline__ float wave_sum(float v) {
#pragma unroll
    for (int o = 1; o < 64; o <<= 1) v += __shfl_xor(v, o);
    return v;
}

namespace pg8 {
constexpr int BM = 256, BK = 64, HALF = 128, HTB = HALF * BK * 2, STAGE_BYTES = 8 * HTB, NXCD = 8, WGM = 8;
__host__ __device__ __forceinline__ int lds_byte(int r, int c) { const int st = (r >> 4) * 2 + (c >> 5), rr = r & 15, cc = c & 31, ob = rr * 64 + cc * 2; return st * 1024 + (ob ^ (((ob >> 9) & 1) << 5)); }
__host__ __device__ __forceinline__ void stage_rc(int b, int& R, int& C) { const int st = b / 1024, sb = b % 1024, swz = sb ^ (((sb >> 9) & 1) << 5); R = (st >> 1) * 16 + swz / 64; C = (st & 1) * 32 + (swz % 64) / 2; }
__host__ __device__ __forceinline__ int perm32(int rho) { const int n = rho >> 4, i = rho & 15; return 8 * (i >> 2) + 4 * n + (i & 3); }

struct Unit { int pm, pn; };
struct Gemm { const bf16_t* A; const bf16_t* Bt; int lda, ldb, K, a_pn_off, nM, nN, pm0, u_lo, u_cnt, c_rot; };

struct Order {
    int nM, nN, nwg, G, c, pm0, u_lo, u_cnt;
    __device__ __forceinline__ void init(const Gemm& g, int G_, int c_) { nM = g.nM; nN = g.nN; nwg = nM * nN; G = G_; pm0 = g.pm0; u_lo = g.u_lo; u_cnt = g.u_cnt ? g.u_cnt : nwg;
        const int cc = c_ - g.c_rot; c = cc < 0 ? cc + G_ : cc; }
    __device__ __forceinline__ bool next(int i, Unit& u) const {
        const long L = (long)i * G + c; if (L >= u_cnt) return false;
        int wgid = (int)L + u_lo; { const int q = nwg / NXCD, r = nwg % NXCD, xcd = wgid % NXCD, off = wgid / NXCD; wgid = (xcd < r ? xcd * (q + 1) : r * (q + 1) + (xcd - r) * q) + off; }
        const int nig = WGM * nN, gid = wgid / nig, fm = gid * WGM, gsz = (nM - fm) < WGM ? (nM - fm) : WGM;
        u.pm = fm + ((wgid % nig) % gsz) + pm0; u.pn = (wgid % nig) / gsz; return true;
    }
};

template <class Epi>
__device__ __forceinline__ void gemm_phase(LAS unsigned char* lds, const Gemm g, const int G, const int cblk, const Epi& E) {
    int tid_ = threadIdx.x; asm volatile("" : "+v"(tid_));
    const int tid = tid_, wid = __builtin_amdgcn_readfirstlane(tid >> 6), lane = tid & 63, wr = wid >> 2, wc = wid & 3, fr = lane & 15, fq = lane >> 4;
    const int nt = g.K / BK;
    Order S; S.init(g, G, cblk);
    unsigned voffA[2], voffB[2];
#pragma unroll
    for (int i = 0; i < 2; ++i) { int R, C; stage_rc(tid * 16 + i * 8192, R, C); const int Rb = (R & ~31) + perm32(R & 31);
        voffA[i] = (unsigned)(R * g.lda + C) * 2u; voffB[i] = (unsigned)(Rb * g.ldb + C) * 2u; }
    const size_t kstep = (size_t)(BK * 2);
    const size_t hstepA = (size_t)HALF * g.lda * 2, hstepB = (size_t)HALF * g.ldb * 2;
    const unsigned ldsw = (unsigned)wid * 1024u;
    const int aoff = lds_byte(wr * 64 + fr, fq * 8), boff = lds_byte(wc * 32 + fr, fq * 8);
#define PG8_UA(u) ((const char*)g.A + ((size_t)(u).pm * BM * g.lda + (size_t)(u).pn * g.a_pn_off) * 2)
#define PG8_UB(u) ((const char*)g.Bt + (size_t)(u).pn * BM * g.ldb * 2)
#define PG8_SA(b, h) (((b) * 2 + (h)) * HTB)
#define PG8_SB(b, h) ((4 + (b) * 2 + (h)) * HTB)
#define PG8_STAGE(bufoff, gbase, voff) do { _Pragma("unroll") for (int _i = 0; _i < 2; ++_i) \
        __builtin_amdgcn_global_load_lds((const unsigned*)((const char*)(gbase) + (voff)[_i]), (LAS unsigned*)(lds + (bufoff) + ldsw + _i * 8192), 16, 0, 0); } while (0)
#define PG8_LDA(dst, b, h) do { _Pragma("unroll") for (int m = 0; m < 4; ++m) _Pragma("unroll") for (int k = 0; k < 2; ++k) dst[m][k] = *(const LAS bf16x8*)(lds + PG8_SA(b, h) + aoff + m * 2048 + k * 1024); } while (0)
#define PG8_LDB(dst, b, h) do { _Pragma("unroll") for (int n = 0; n < 2; ++n) _Pragma("unroll") for (int k = 0; k < 2; ++k) dst[n][k] = *(const LAS bf16x8*)(lds + PG8_SB(b, h) + boff + n * 2048 + k * 1024); } while (0)
#define PG8_MMA(ai, bj, At, Bt) do { __builtin_amdgcn_s_setprio(1); _Pragma("unroll") for (int m = 0; m < 4; ++m) _Pragma("unroll") for (int n = 0; n < 2; ++n) _Pragma("unroll") for (int k = 0; k < 2; ++k) \
        acc[ai][bj][m][n] = __builtin_amdgcn_mfma_f32_16x16x32_bf16(Bt[n][k], At[m][k], acc[ai][bj][m][n], 0, 0, 0); __builtin_amdgcn_s_setprio(0); } while (0)
#define PG8_WAIT_V(n) asm volatile("s_waitcnt vmcnt(" #n ")" ::: "memory")
#define PG8_WAIT_L(n) asm volatile("s_waitcnt lgkmcnt(" #n ")" ::: "memory")
#define PG8_BAR __builtin_amdgcn_s_barrier()
#define PG8_SCHED __builtin_amdgcn_sched_barrier(0)
    Unit cur, nxt; int ui = 0;
    if (!S.next(0, cur)) return;
    if (E.ssp_rows()) {
        LAS float* tab = (LAS float*)(lds + STAGE_BYTES + 8192);
        Unit uu;
        for (int i = 0; i < 8 && S.next(i, uu); ++i) { if (tid < 256) tab[i * 256 + tid] = rstd_from(E.ssp_rows() + (size_t)(uu.pm * BM + tid) * 4); }
        asm volatile("s_waitcnt vmcnt(0) lgkmcnt(0)\n\ts_barrier" ::: "memory");
    }
    f32x4 acc[2][2][4][2];
#pragma unroll
    for (int a = 0; a < 2; ++a)
#pragma unroll
        for (int b = 0; b < 2; ++b)
#pragma unroll
            for (int m = 0; m < 4; ++m)
#pragma unroll
                for (int n = 0; n < 2; ++n) acc[a][b][m][n] = (f32x4){0.f, 0.f, 0.f, 0.f};
    bf16x8 At[4][2], B0[2][2], B1[2][2];
    const char* cA = PG8_UA(cur); const char* cB = PG8_UB(cur);
    PG8_STAGE(PG8_SB(0, 0), cB, voffB); PG8_STAGE(PG8_SB(0, 1), cB + hstepB, voffB); PG8_STAGE(PG8_SA(0, 0), cA, voffA); PG8_STAGE(PG8_SA(0, 1), cA + hstepA, voffA);
    if (wr == 1) PG8_BAR;
    PG8_WAIT_V(2); PG8_BAR;
    PG8_STAGE(PG8_SB(1, 0), cB + kstep, voffB); PG8_STAGE(PG8_SA(1, 0), cA + kstep, voffA); PG8_STAGE(PG8_SB(1, 1), cB + hstepB + kstep, voffB);
    PG8_WAIT_V(6); PG8_BAR;
    for (;;) {
        const bool has_next = S.next(ui + 1, nxt);
        const char* nA = has_next ? PG8_UA(nxt) : cA; const char* nB = has_next ? PG8_UB(nxt) : cB;
        for (int t = 0; t < nt; t += 2) {
            const bool last = (t == nt - 2);
            const char* a1 = cA + (size_t)(t + 1) * kstep;
            const char* a2 = last ? nA : cA + (size_t)(t + 2) * kstep; const char* b2 = last ? nB : cB + (size_t)(t + 2) * kstep;
            const char* a3 = a2 + kstep; const char* b3 = b2 + kstep;
            PG8_LDB(B0, 0, 0); PG8_LDB(B1, 0, 1); PG8_SCHED; PG8_LDA(At, 0, 0); PG8_STAGE(PG8_SA(1, 1), a1 + hstepA, voffA);
            PG8_WAIT_V(8); PG8_WAIT_L(0); PG8_BAR; PG8_MMA(0, 0, At, B0); PG8_MMA(0, 1, At, B1); PG8_BAR; PG8_SCHED;
            PG8_LDA(At, 0, 1); PG8_STAGE(PG8_SB(0, 0), b2, voffB); PG8_STAGE(PG8_SB(0, 1), b2 + hstepB, voffB); PG8_STAGE(PG8_SA(0, 0), a2, voffA);
            PG8_WAIT_V(8); PG8_WAIT_L(0); PG8_BAR; PG8_MMA(1, 0, At, B0); PG8_MMA(1, 1, At, B1); PG8_BAR; PG8_SCHED;
            PG8_LDB(B0, 1, 0); PG8_LDB(B1, 1, 1); PG8_SCHED; PG8_LDA(At, 1, 0); PG8_STAGE(PG8_SA(0, 1), a2 + hstepA, voffA);
            PG8_WAIT_V(8); PG8_WAIT_L(0); PG8_BAR; PG8_MMA(0, 0, At, B0); PG8_MMA(0, 1, At, B1); PG8_BAR; PG8_SCHED;
            PG8_LDA(At, 1, 1); PG8_STAGE(PG8_SB(1, 0), b3, voffB); PG8_STAGE(PG8_SB(1, 1), b3 + hstepB, voffB); PG8_STAGE(PG8_SA(1, 0), a3, voffA);
            PG8_WAIT_V(8); PG8_WAIT_L(0); PG8_BAR; PG8_MMA(1, 0, At, B0); PG8_MMA(1, 1, At, B1); PG8_BAR; PG8_SCHED;
        }
        if (wr == 0) PG8_BAR;
        E(acc, cur, wr, wc, fr, fq, (const LAS float*)(lds + STAGE_BYTES + 8192) + (ui & 7) * 256);
        if (!has_next) break;
#pragma unroll
        for (int a = 0; a < 2; ++a)
#pragma unroll
            for (int b = 0; b < 2; ++b)
#pragma unroll
                for (int m = 0; m < 4; ++m)
#pragma unroll
                    for (int n = 0; n < 2; ++n) acc[a][b][m][n] = (f32x4){0.f, 0.f, 0.f, 0.f};
        cur = nxt; cA = nA; cB = nB; ++ui;
        if (wr == 1) PG8_BAR;
    }
    PG8_WAIT_V(0);
    PG8_BAR;
#undef PG8_UA
#undef PG8_UB
#undef PG8_SA
#undef PG8_SB
#undef PG8_STAGE
#undef PG8_LDA
#undef PG8_LDB
#undef PG8_MMA
#undef PG8_WAIT_V
#undef PG8_WAIT_L
#undef PG8_BAR
#undef PG8_SCHED
}

struct EpiResid {
    const float* base_lo; const float* base_hi; int split_row; int base_f32;
    bf16_t* xb; float* ssp; const float* cscale; LAS float* red;
    __device__ __forceinline__ const float* ssp_rows() const { return nullptr; }
    __device__ __forceinline__ void operator()(const f32x4 (&acc)[2][2][4][2], const Unit& u, int wr, int wc, int fr, int fq, const LAS float* rstab) const {
        const int rl0 = wr * 64 + fr, col0 = u.pn * BM + wc * 32 + 8 * fq;
        f32x4 cs[2][2];
#pragma unroll
        for (int bj = 0; bj < 2; ++bj)
#pragma unroll
            for (int n = 0; n < 2; ++n) cs[bj][n] = cscale ? *(const f32x4*)(cscale + col0 + bj * HALF + 4 * n) : (f32x4){1.f, 1.f, 1.f, 1.f};
        const float* bp = (u.pm * BM < split_row) ? base_lo : (base_hi - (size_t)split_row * D);
#define RESID_BODY(m_, bj_, b0_, b1_) do { \
            const f32x4 v0 = (b0_) + acc[ai][bj_][m_][0] * cs[bj_][0], v1 = (b1_) + acc[ai][bj_][m_][1] * cs[bj_][1]; \
            ssr[m_] += (v0[0] * v0[0] + v0[1] * v0[1]) + (v0[2] * v0[2] + v0[3] * v0[3]) + (v1[0] * v1[0] + v1[1] * v1[1]) + (v1[2] * v1[2] + v1[3] * v1[3]); \
            u32x4 w; w.x = pk_bf16(v0[0], v0[1]); w.y = pk_bf16(v0[2], v0[3]); w.z = pk_bf16(v1[0], v1[1]); w.w = pk_bf16(v1[2], v1[3]); \
            *(u32x4*)(xb + offa + (size_t)(m_) * 16 * D + (bj_) * HALF) = w; } while (0)
#pragma unroll
        for (int ai = 0; ai < 2; ++ai) {
            int rla = rl0 + ai * HALF; asm volatile("" : "+v"(rla) :: "memory");
            const size_t offa = (size_t)(u.pm * BM + rla) * D + col0;
            float ssr[4] = {0.f, 0.f, 0.f, 0.f};
            if (!base_f32) {
                u32x4 pre[4][2];
#pragma unroll
                for (int m = 0; m < 4; ++m)
#pragma unroll
                    for (int bj = 0; bj < 2; ++bj) pre[m][bj] = *(const u32x4*)(xb + offa + (size_t)m * 16 * D + bj * HALF);
#pragma unroll
                for (int m = 0; m < 4; ++m)
#pragma unroll
                    for (int bj = 0; bj < 2; ++bj) { const u32x4 w0 = pre[m][bj];
                        const f32x4 b0 = (f32x4){__uint_as_float(w0.x << 16), __uint_as_float(w0.x & 0xffff0000u), __uint_as_float(w0.y << 16), __uint_as_float(w0.y & 0xffff0000u)};
                        const f32x4 b1 = (f32x4){__uint_as_float(w0.z << 16), __uint_as_float(w0.z & 0xffff0000u), __uint_as_float(w0.w << 16), __uint_as_float(w0.w & 0xffff0000u)};
                        RESID_BODY(m, bj, b0, b1); }
            } else {
#pragma unroll
                for (int mp = 0; mp < 2; ++mp) {
                    f32x4 pf[2][2][2];
#pragma unroll
                    for (int mm = 0; mm < 2; ++mm)
#pragma unroll
                        for (int bj = 0; bj < 2; ++bj) { const float* p = bp + offa + (size_t)(2 * mp + mm) * 16 * D + bj * HALF; pf[mm][bj][0] = *(const f32x4*)p; pf[mm][bj][1] = *(const f32x4*)(p + 4); }
#pragma unroll
                    for (int mm = 0; mm < 2; ++mm)
#pragma unroll
                        for (int bj = 0; bj < 2; ++bj) RESID_BODY(2 * mp + mm, bj, pf[mm][bj][0], pf[mm][bj][1]);
                    asm volatile("" ::: "memory");
                }
            }
#pragma unroll
            for (int m = 0; m < 4; ++m) { float ss = ssr[m]; ss += __shfl_xor(ss, 16); ss += __shfl_xor(ss, 32); if (fq == 0) red[(rla + m * 16) * 4 + wc] = ss; }
        }
#undef RESID_BODY
        asm volatile("s_waitcnt lgkmcnt(0)\n\ts_barrier" ::: "memory");
        const int t = threadIdx.x;
        if (t < 256) { const f32x4 p = *(const LAS f32x4*)(red + t * 4); ssp[(size_t)(u.pm * BM + t) * 4 + u.pn] = (p[0] + p[1]) + (p[2] + p[3]); }
    }
};
struct EpiRowScale {
    bf16_t* out; int ldc; const float* ssp; float cst; int tsplit; bf16_t* vt; int t_pm_stride, t_ld;
    __device__ __forceinline__ const float* ssp_rows() const { return ssp; }
    __device__ __forceinline__ void operator()(const f32x4 (&acc)[2][2][4][2], const Unit& u, int wr, int wc, int fr, int fq, const LAS float* rstab) const {
        const int rl0 = wr * 64 + fr, col0 = u.pn * BM + wc * 32 + 8 * fq;
        const bool tr = u.pn >= tsplit;
        float rs[8];
#pragma unroll
        for (int i = 0; i < 8; ++i) rs[i] = rstab[rl0 + (i >> 2) * HALF + (i & 3) * 16] * cst;
#pragma unroll
        for (int ai = 0; ai < 2; ++ai)
#pragma unroll
            for (int m = 0; m < 4; ++m) {
                int rl = rl0 + ai * HALF + m * 16; asm volatile("" : "+v"(rl) :: "memory");
                const int row = u.pm * BM + rl;
#pragma unroll
                for (int bj = 0; bj < 2; ++bj) {
                    const f32x4 v0 = acc[ai][bj][m][0] * rs[ai * 4 + m], v1 = acc[ai][bj][m][1] * rs[ai * 4 + m];
                    u32x4 w; w.x = pk_bf16(v0[0], v0[1]); w.y = pk_bf16(v0[2], v0[3]); w.z = pk_bf16(v1[0], v1[1]); w.w = pk_bf16(v1[2], v1[3]);
                    if (!tr) *(u32x4*)(out + (size_t)row * ldc + col0 + bj * HALF) = w;
                    else { bf16_t* p = vt + (size_t)u.pm * t_pm_stride + (size_t)(col0 - tsplit * BM + bj * HALF) * t_ld + rl;
                        p[0] = (bf16_t)w.x; p[(size_t)t_ld] = (bf16_t)(w.x >> 16); p[(size_t)2 * t_ld] = (bf16_t)w.y; p[(size_t)3 * t_ld] = (bf16_t)(w.y >> 16);
                        p[(size_t)4 * t_ld] = (bf16_t)w.z; p[(size_t)5 * t_ld] = (bf16_t)(w.z >> 16); p[(size_t)6 * t_ld] = (bf16_t)w.w; p[(size_t)7 * t_ld] = (bf16_t)(w.w >> 16); }
                }
            }
    }
};
struct EpiUp {
    bf16_t* out; const float* ssp;
    __device__ __forceinline__ const float* ssp_rows() const { return ssp; }
    __device__ __forceinline__ void operator()(const f32x4 (&acc)[2][2][4][2], const Unit& u, int wr, int wc, int fr, int fq, const LAS float* rstab) const {
        const int row0 = u.pm * BM + wr * 64 + fr, col0 = u.pn * BM + wc * 32 + 8 * fq;
        float rs[8];
#pragma unroll
        for (int i = 0; i < 8; ++i) rs[i] = rstab[wr * 64 + fr + (i >> 2) * HALF + (i & 3) * 16];
#pragma unroll
        for (int ai = 0; ai < 2; ++ai)
#pragma unroll
            for (int m = 0; m < 4; ++m) {
                int row = row0 + ai * HALF + m * 16; asm volatile("" : "+v"(row) :: "memory");
#pragma unroll
                for (int bj = 0; bj < 2; ++bj) {
                    f32x4 v0 = acc[ai][bj][m][0] * rs[ai * 4 + m], v1 = acc[ai][bj][m][1] * rs[ai * 4 + m];
#pragma unroll
                    for (int e = 0; e < 4; ++e) { v0[e] = fmaxf(v0[e], 0.f); v0[e] *= v0[e]; v1[e] = fmaxf(v1[e], 0.f); v1[e] *= v1[e]; }
                    u32x4 w; w.x = pk_bf16(v0[0], v0[1]); w.y = pk_bf16(v0[2], v0[3]); w.z = pk_bf16(v1[0], v1[1]); w.w = pk_bf16(v1[2], v1[3]);
                    *(u32x4*)(out + (size_t)row * FF + col0 + bj * HALF) = w;
                }
            }
    }
};
struct EpiQKV {
    bf16_t* qb; bf16_t* kw; bf16_t* vt; const float* ssp; const float* ropec; const float* ropes;
    __device__ __forceinline__ const float* ssp_rows() const { return ssp; }
    __device__ __forceinline__ void operator()(const f32x4 (&acc)[2][2][4][2], const Unit& u, int wr, int wc, int fr, int fq, const LAS float* rstab) const {
        const int row0 = u.pm * BM + wr * 64 + fr, colt = wc * 32 + 8 * fq;
        const int dd = 16 * (wc & 1) + 4 * fq;
        float rs[8];
#pragma unroll
        for (int i = 0; i < 8; ++i) rs[i] = rstab[wr * 64 + fr + (i >> 2) * HALF + (i & 3) * 16];
        if (u.pn < 5) {
            const float qs = (u.pn < 4 ? 0.125f * LOG2E : 1.0f);
#pragma unroll
            for (int ai = 0; ai < 2; ++ai) {
                int rowa = row0 + ai * HALF; asm volatile("" : "+v"(rowa) :: "memory");
                f32x4 c[4], sn[4];
#pragma unroll
                for (int m = 0; m < 4; ++m) { const int row = rowa + m * 16; const int pos = row < TP ? (row & (SEQP - 1)) : (row & (SEQS - 1));
                    c[m] = *(const f32x4*)(ropec + pos * 32 + dd); sn[m] = *(const f32x4*)(ropes + pos * 32 + dd); }
#pragma unroll
                for (int m = 0; m < 4; ++m) {
                    const int row = rowa + m * 16; const float sc = rs[ai * 4 + m] * qs;
#pragma unroll
                    for (int bj = 0; bj < 2; ++bj) {
                        const f32x4 x1 = acc[ai][bj][m][0] * sc, x2 = acc[ai][bj][m][1] * sc;
                        const f32x4 o1 = x1 * c[m] - x2 * sn[m], o2 = x2 * c[m] + x1 * sn[m];
                        u32x4 w; w.x = pk_bf16(o1[0], o1[1]); w.y = pk_bf16(o1[2], o1[3]); w.z = pk_bf16(o2[0], o2[1]); w.w = pk_bf16(o2[2], o2[3]);
                        if (u.pn < 4) *(u32x4*)(qb + (size_t)row * D + u.pn * BM + colt + bj * HALF) = w;
                        else *(u32x4*)(kw + (size_t)row * 256 + colt + bj * HALF) = w;
                    }
                }
            }
        } else {
#pragma unroll
            for (int ai = 0; ai < 2; ++ai)
#pragma unroll
                for (int m = 0; m < 4; ++m) {
                    int row = row0 + ai * HALF + m * 16; asm volatile("" : "+v"(row) :: "memory");
#pragma unroll
                    for (int bj = 0; bj < 2; ++bj) {
                        const f32x4 v0 = acc[ai][bj][m][0] * rs[ai * 4 + m], v1 = acc[ai][bj][m][1] * rs[ai * 4 + m];
                        u32x4 w; w.x = pk_bf16(v0[0], v0[1]); w.y = pk_bf16(v0[2], v0[3]); w.z = pk_bf16(v1[0], v1[1]); w.w = pk_bf16(v1[2], v1[3]);
                        bf16_t* p = vt + (size_t)(colt + bj * HALF) * T + row;
                        p[0] = (bf16_t)w.x; p[(size_t)T] = (bf16_t)(w.x >> 16); p[(size_t)2 * T] = (bf16_t)w.y; p[(size_t)3 * T] = (bf16_t)(w.y >> 16);
                        p[(size_t)4 * T] = (bf16_t)w.z; p[(size_t)5 * T] = (bf16_t)(w.z >> 16); p[(size_t)6 * T] = (bf16_t)w.w; p[(size_t)7 * T] = (bf16_t)(w.w >> 16);
                    }
                }
        }
    }
};
}

#define MFMA32(a, b, c) __builtin_amdgcn_mfma_f32_32x32x16_bf16((a), (b), (c), 0, 0, 0)
#define WG_BAR_LDS() asm volatile("s_waitcnt lgkmcnt(0)\n\ts_barrier" ::: "memory")
__device__ __forceinline__ int swap23(int r) { return (r & 0x13) | ((r & 4) << 1) | ((r & 8) >> 1); }
__device__ __forceinline__ bf16x8 pack8(const f32x16& x, int s) {
    u32x4 p; p.x = pk_bf16(x[8 * s + 0], x[8 * s + 1]); p.y = pk_bf16(x[8 * s + 2], x[8 * s + 3]); p.z = pk_bf16(x[8 * s + 4], x[8 * s + 5]); p.w = pk_bf16(x[8 * s + 6], x[8 * s + 7]);
    return __builtin_bit_cast(bf16x8, p);
}
__device__ __forceinline__ float max3(float a, float b, float c) { return __builtin_fmaxf(__builtin_fmaxf(a, b), c); }
__device__ __forceinline__ float vmax16(const f32x16& x) {
    float a = max3(x[0], x[1], x[2]), b = max3(x[3], x[4], x[5]), c = max3(x[6], x[7], x[8]), d = max3(x[9], x[10], x[11]);
    a = max3(a, x[12], x[13]); b = max3(b, x[14], x[15]);
    return __builtin_fmaxf(max3(a, b, c), d);
}

constexpr int XA_KP = 144, XA_VP = 528, XA_BUF = 256 * XA_KP;
__device__ __forceinline__ void xattn_unit(LAS unsigned char* lds, bf16_t* QO, const bf16_t* KM, const bf16_t* VMT, int qt, int h) {
    int tid_ = threadIdx.x; asm volatile("" : "+v"(tid_));
    const int tid = tid_, lane = tid & 63, wid = __builtin_amdgcn_readfirstlane(tid >> 6), r32 = lane & 31, hi = lane >> 5;
    const int seq = qt < 128 ? (qt >> 3) : 16 + ((qt - 128) >> 5);
    const bf16_t* Kg = KM + (size_t)(seq * 256) * D + h * 256;
    const bf16_t* Vg = VMT + ((size_t)seq * D + h * 256) * 256;
    bf16_t* Qg = QO + (size_t)(qt * 256 + wid * 32 + r32) * D + h * 256;
    u32x4 st[4];
#define XA_LOADK(c) do { _Pragma("unroll") for (int i = 0; i < 4; ++i) { const int ch = tid + 512 * i, row = ch >> 3, c16 = ch & 7; st[i] = *(const u32x4*)(Kg + (size_t)row * D + (c) * 64 + c16 * 8); } } while (0)
#define XA_LOADV(c) do { _Pragma("unroll") for (int i = 0; i < 4; ++i) { const int ch = tid + 512 * i, row = ch >> 5, c16 = ch & 31; st[i] = *(const u32x4*)(Vg + (size_t)((c) * 64 + row) * 256 + c16 * 8); } } while (0)
#define XA_WRK(buf) do { _Pragma("unroll") for (int i = 0; i < 4; ++i) { const int ch = tid + 512 * i, row = ch >> 3, c16 = ch & 7; *(LAS u32x4*)(lds + (buf) * XA_BUF + row * XA_KP + c16 * 16) = st[i]; } } while (0)
#define XA_WRV(buf) do { _Pragma("unroll") for (int i = 0; i < 4; ++i) { const int ch = tid + 512 * i, row = ch >> 5, c16 = ch & 31; *(LAS u32x4*)(lds + (buf) * XA_BUF + row * XA_VP + c16 * 16) = st[i]; } } while (0)
    XA_LOADK(0); XA_WRK(0); WG_BAR_LDS();
    f32x16 sc[8];
#pragma unroll
    for (int kb = 0; kb < 8; ++kb)
#pragma unroll
        for (int r = 0; r < 16; ++r) sc[kb][r] = 0.f;
    const int koff = swap23(r32) * XA_KP + hi * 16;
    bf16x8 qf[4];
#pragma unroll
    for (int ds = 0; ds < 4; ++ds) qf[ds] = *(const bf16x8*)(Qg + ds * 16 + hi * 8);
#pragma unroll 1
    for (int c = 0; c < 4; ++c) {
        if (c < 3) XA_LOADK(c + 1); else XA_LOADV(0);
        const LAS unsigned char* kb_base = lds + (c & 1) * XA_BUF + koff;
        {
            bf16x8 kf[2][4];
#pragma unroll
            for (int j = 0; j < 4; ++j) kf[0][j] = *(const LAS bf16x8*)(kb_base + j * 32 * XA_KP);
#pragma unroll
            for (int g = 0; g < 8; ++g) {
                if (g < 7) {
#pragma unroll
                    for (int j = 0; j < 4; ++j) kf[(g + 1) & 1][j] = *(const LAS bf16x8*)(kb_base + (4 * ((g + 1) & 1) + j) * 32 * XA_KP + ((g + 1) >> 1) * 32);
                }
                __builtin_amdgcn_sched_barrier(0);
#pragma unroll
                for (int j = 0; j < 4; ++j) sc[4 * (g & 1) + j] = MFMA32(kf[g & 1][j], qf[g >> 1], sc[4 * (g & 1) + j]);
                __builtin_amdgcn_sched_barrier(0);
            }
        }
        if (c < 3) {
#pragma unroll
            for (int ds = 0; ds < 4; ++ds) qf[ds] = *(const bf16x8*)(Qg + (c + 1) * 64 + ds * 16 + hi * 8);
        }
        if (c < 3) XA_WRK((c + 1) & 1); else XA_WRV(0);
        WG_BAR_LDS();
    }
    float mx = vmax16(sc[0]);
#pragma unroll
    for (int kb = 1; kb < 8; ++kb) mx = fmaxf(mx, vmax16(sc[kb]));
    { const auto rr = __builtin_amdgcn_permlane32_swap(__float_as_uint(mx), __float_as_uint(mx), false, false); mx = fmaxf(__uint_as_float(rr[0]), __uint_as_float(rr[1])); }
    float l = 0.f;
#pragma unroll
    for (int kb = 0; kb < 8; ++kb)
#pragma unroll
        for (int r = 0; r < 16; ++r) { const float p = __builtin_amdgcn_exp2f(sc[kb][r] - mx); sc[kb][r] = p; l += p; }
    { const auto rr = __builtin_amdgcn_permlane32_swap(__float_as_uint(l), __float_as_uint(l), false, false); l = __uint_as_float(rr[0]) + __uint_as_float(rr[1]); }
    const float inv = 1.0f / l;
    bf16x8 pf[16];
#pragma unroll
    for (int kb = 0; kb < 8; ++kb) { pf[2 * kb] = pack8(sc[kb], 0); pf[2 * kb + 1] = pack8(sc[kb], 1); }
    const int voff = r32 * XA_VP + hi * 16;
#pragma unroll 1
    for (int c = 0; c < 4; ++c) {
        if (c < 3) XA_LOADV(c + 1);
        f32x16 o[2];
#pragma unroll
        for (int db = 0; db < 2; ++db)
#pragma unroll
            for (int r = 0; r < 16; ++r) o[db][r] = 0.f;
        const LAS unsigned char* vb_base = lds + (c & 1) * XA_BUF + voff;
        {
            bf16x8 vf[2][4];
#pragma unroll
            for (int j = 0; j < 4; ++j) vf[0][j] = *(const LAS bf16x8*)(vb_base + (j & 1) * 32 * XA_VP + (j >> 1) * 32);
#pragma unroll
            for (int g = 0; g < 8; ++g) {
                if (g < 7) {
#pragma unroll
                    for (int j = 0; j < 4; ++j) vf[(g + 1) & 1][j] = *(const LAS bf16x8*)(vb_base + (j & 1) * 32 * XA_VP + (2 * (g + 1) + (j >> 1)) * 32);
                }
                __builtin_amdgcn_sched_barrier(0);
#pragma unroll
                for (int j = 0; j < 4; ++j) o[j & 1] = MFMA32(vf[g & 1][j], pf[2 * g + (j >> 1)], o[j & 1]);
                __builtin_amdgcn_sched_barrier(0);
            }
        }
#pragma unroll
        for (int db = 0; db < 2; ++db)
#pragma unroll
            for (int gq = 0; gq < 4; ++gq) {
                u32x2 w; w.x = pk_bf16(o[db][4 * gq] * inv, o[db][4 * gq + 1] * inv); w.y = pk_bf16(o[db][4 * gq + 2] * inv, o[db][4 * gq + 3] * inv);
                *(u32x2*)(Qg + c * 64 + db * 32 + gq * 8 + hi * 4) = w;
            }
        if (c < 3) XA_WRV((c + 1) & 1);
        WG_BAR_LDS();
    }
#undef XA_LOADK
#undef XA_LOADV
#undef XA_WRK
#undef XA_WRV
}

constexpr int WA_P = 144, WA_TB = 64 * WA_P;
struct WaUnit { int q0, t_lo, t_hi, hq; };
__device__ __forceinline__ WaUnit wa_unit(int u, int wid) {
    WaUnit w; const int qt = u >> 3; w.hq = 2 * (u & 7) + (wid >> 2);
    w.q0 = qt * 128;
    const int S = w.q0 < TP ? SEQP : SEQS;
    const int q0s = w.q0 < TP ? (w.q0 & (SEQP - 1)) : (w.q0 & (SEQS - 1));
    w.t_lo = (q0s == 0) ? 2 : 0; w.t_hi = (q0s + 128 == S) ? 3 : 5;
    return w;
}
__device__ __forceinline__ void wattn_phase(LAS unsigned char* lds, bf16_t* QO, const bf16_t* KW, const bf16_t* VT, const float* sinks, int vcu, int G) {
    int tid_ = threadIdx.x; asm volatile("" : "+v"(tid_));
    const int tid = tid_, lane = tid & 63, wid = __builtin_amdgcn_readfirstlane(tid >> 6), r32 = lane & 31, hi = lane >> 5;
    constexpr int NU = (T / 128) * 8;
    const int wj = wid & 3, tw_lo = wj >> 1, tw_hi = (wj >> 1) + 4;
    const int srow = tid >> 3, sc16 = tid & 7;
    const int soff = srow * WA_P + sc16 * 16;
    const int koff = swap23(r32) * WA_P + hi * 16, voff = r32 * WA_P + hi * 16;
    const int qrel = wj * 32 + r32;
#define WA_KG(w, t) (KW + (size_t)((w).q0 - 128 + (t) * 64 + srow) * 256 + ((w).hq >> 2) * 64 + sc16 * 8)
#define WA_VG(w, t) (VT + (size_t)(((w).hq >> 2) * 64 + srow) * T + ((w).q0 - 128) + (t) * 64 + sc16 * 8)
#define WA_QG(w) (QO + (size_t)((w).q0 + wj * 32 + r32) * D + (w).hq * 64)
    if (vcu >= NU) return;
    WaUnit w = wa_unit(vcu, wid);
    u32x4 stk = *(const u32x4*)WA_KG(w, w.t_lo), stv = *(const u32x4*)WA_VG(w, w.t_lo);
    bf16x8 qf[4];
#pragma unroll
    for (int ds = 0; ds < 4; ++ds) qf[ds] = *(const bf16x8*)(WA_QG(w) + ds * 16 + hi * 8);
    for (int u = vcu; u < NU; u += G) {
        *(LAS u32x4*)(lds + (w.t_lo & 1) * WA_TB + soff) = stk; *(LAS u32x4*)(lds + (2 + (w.t_lo & 1)) * WA_TB + soff) = stv;
        WG_BAR_LDS();
        const bool has_next = (u + G < NU);
        WaUnit wn = w; if (has_next) wn = wa_unit(u + G, wid);
        bf16x8 qn[4];
#pragma unroll
        for (int ds = 0; ds < 4; ++ds) qn[ds] = qf[ds];
        float mrun = 0.f, l = 0.f;
        f32x16 o[2];
#pragma unroll
        for (int db = 0; db < 2; ++db)
#pragma unroll
            for (int r = 0; r < 16; ++r) o[db][r] = 0.f;
        const int t_first = w.t_lo > tw_lo ? w.t_lo : tw_lo;
#pragma unroll 1
        for (int t = w.t_lo; t <= w.t_hi; ++t) {
            if (t < w.t_hi) { stk = *(const u32x4*)WA_KG(w, t + 1); stv = *(const u32x4*)WA_VG(w, t + 1); }
            else if (has_next) { stk = *(const u32x4*)WA_KG(wn, wn.t_lo); stv = *(const u32x4*)WA_VG(wn, wn.t_lo);
#pragma unroll
                for (int ds = 0; ds < 4; ++ds) qn[ds] = *(const bf16x8*)(WA_QG(wn) + ds * 16 + hi * 8); }
            if (t >= tw_lo && t <= tw_hi) {
                const LAS unsigned char* kb_base = lds + (t & 1) * WA_TB + koff;
                const LAS unsigned char* vb_base = lds + (2 + (t & 1)) * WA_TB + voff;
                f32x16 s[2];
                const float negm = -mrun;
#pragma unroll
                for (int kb = 0; kb < 2; ++kb)
#pragma unroll
                    for (int r = 0; r < 16; ++r) s[kb][r] = negm;
                bf16x8 kf[8], vf[8];
#pragma unroll
                for (int j = 0; j < 8; ++j) kf[j] = *(const LAS bf16x8*)(kb_base + (j & 1) * 32 * WA_P + (j >> 1) * 32);
#pragma unroll
                for (int j = 0; j < 8; ++j) vf[j] = *(const LAS bf16x8*)(vb_base + (j & 1) * 32 * WA_P + (j >> 1) * 32);
                __builtin_amdgcn_sched_barrier(0);
#pragma unroll
                for (int j = 0; j < 8; ++j) s[j & 1] = MFMA32(kf[j], qf[j >> 1], s[j & 1]);
                __builtin_amdgcn_sched_barrier(0);
                const bool full = (64 * t >= wj * 32 + 31) && (64 * t + 63 <= wj * 32 + 256);
                if (!full) {
                    const int kap0 = 64 * t + 8 * hi - qrel;
#pragma unroll
                    for (int kb = 0; kb < 2; ++kb)
#pragma unroll
                        for (int r = 0; r < 16; ++r) { const int dlt = kap0 + 32 * kb + 16 * (r >> 3) + (r & 7); if (dlt < 0 || dlt > 256) s[kb][r] = -1e30f; }
                }
                float mx = __builtin_fmaxf(vmax16(s[0]), vmax16(s[1]));
                mx = __builtin_fmaxf(mx, __shfl_xor(mx, 32));
                const bool first = (t == t_first);
                if (first || __any(mx > 8.0f)) {
                    const float dl = first ? mx : __builtin_fmaxf(mx, 0.f);
                    mrun += dl;
#pragma unroll
                    for (int kb = 0; kb < 2; ++kb)
#pragma unroll
                        for (int r = 0; r < 16; ++r) s[kb][r] -= dl;
                    if (!first) {
                        const float alpha = __builtin_amdgcn_exp2f(-dl);
                        l *= alpha;
#pragma unroll
                        for (int db = 0; db < 2; ++db)
#pragma unroll
                            for (int r = 0; r < 16; ++r) o[db][r] *= alpha;
                    }
                }
                float ls = 0.f;
#pragma unroll
                for (int kb = 0; kb < 2; ++kb)
#pragma unroll
                    for (int r = 0; r < 16; ++r) { const float p = __builtin_amdgcn_exp2f(s[kb][r]); s[kb][r] = p; ls += p; }
                l += ls;
                bf16x8 pf[4];
                pf[0] = pack8(s[0], 0); pf[1] = pack8(s[0], 1); pf[2] = pack8(s[1], 0); pf[3] = pack8(s[1], 1);
                __builtin_amdgcn_s_setprio(0);
#pragma unroll
                for (int j = 0; j < 8; ++j) o[j & 1] = MFMA32(vf[j], pf[j >> 1], o[j & 1]);
            }
            if (t < w.t_hi) { *(LAS u32x4*)(lds + ((t + 1) & 1) * WA_TB + soff) = stk; *(LAS u32x4*)(lds + (2 + ((t + 1) & 1)) * WA_TB + soff) = stv; }
            WG_BAR_LDS();
        }
        l += __shfl_xor(l, 32);
        l += __builtin_amdgcn_exp2f(sinks[w.hq] * LOG2E - mrun);
        const float inv = 1.0f / l;
        bf16_t* Qg = WA_QG(w);
#pragma unroll
        for (int db = 0; db < 2; ++db)
#pragma unroll
            for (int gq = 0; gq < 4; ++gq) {
                u32x2 ww; ww.x = pk_bf16(o[db][4 * gq] * inv, o[db][4 * gq + 1] * inv); ww.y = pk_bf16(o[db][4 * gq + 2] * inv, o[db][4 * gq + 3] * inv);
                *(u32x2*)(Qg + db * 32 + gq * 8 + hi * 4) = ww;
            }
        w = wn;
#pragma unroll
        for (int ds = 0; ds < 4; ++ds) qf[ds] = qn[ds];
    }
#undef WA_KG
#undef WA_VG
#undef WA_QG
}

__device__ __forceinline__ unsigned f2bf(float f) { return pk_bf16(f, 0.f) & 0xffffu; }
__device__ __forceinline__ void p0_transpose_item(const float* W, int K, int N, bf16_t* WT, const float* gain, int permlim, LAS float* scr, int item, int lane) {
    const int nblk = N / 32, kb = item / nblk, nb = item % nblk, k0 = 64 * kb, n0 = 32 * nb;
    const float* src = W + (size_t)(k0 + (lane >> 5)) * N + n0 + (lane & 31);
    float v[32];
#pragma unroll
    for (int i = 0; i < 32; ++i) v[i] = src[(size_t)(2 * i) * N];
    const int c = lane & 7;
    f32x4 g0 = (f32x4){1.f, 1.f, 1.f, 1.f}, g1 = g0;
    if (gain) { g0 = *(const f32x4*)(gain + k0 + 8 * c); g1 = *(const f32x4*)(gain + k0 + 8 * c + 4); }
#pragma unroll
    for (int i = 0; i < 32; ++i) scr[(2 * i + (lane >> 5)) * 33 + (lane & 31)] = v[i];
    asm volatile("s_waitcnt lgkmcnt(0)" ::: "memory");
#pragma unroll
    for (int j = 0; j < 4; ++j) { const int n = (lane >> 3) + 8 * j; const LAS float* s = scr + (8 * c) * 33 + n;
        u32x4 o; o.x = pk_bf16(s[0 * 33] * g0[0], s[1 * 33] * g0[1]); o.y = pk_bf16(s[2 * 33] * g0[2], s[3 * 33] * g0[3]); o.z = pk_bf16(s[4 * 33] * g1[0], s[5 * 33] * g1[1]); o.w = pk_bf16(s[6 * 33] * g1[2], s[7 * 33] * g1[3]);
        int nn = n0 + n;
        if (nn < permlim) { const int d = nn & 63; const int p = (d < 32) ? (8 * (d >> 2) + (d & 3)) : (8 * ((d - 32) >> 2) + 4 + (d & 3)); nn = (nn & ~63) | p; }
        *(u32x4*)(WT + (size_t)nn * K + k0 + 8 * c) = o; }
    asm volatile("s_waitcnt lgkmcnt(0)" ::: "memory");
}

struct Args { const float* in[19]; float* out; unsigned char* ws; int lo, hi; };
typedef const __attribute__((address_space(4))) unsigned char* karg_t;
typedef const float* cfptr_t;
#define KIN(i) (*(const __attribute__((address_space(4))) cfptr_t*)(kp + 8 * (i)))
#define KOUT (*(float* const __attribute__((address_space(4)))*)(kp + 152))
#define KWS (*(unsigned char* const __attribute__((address_space(4)))*)(kp + 160))

constexpr size_t WS_QCTR = 8192;
__device__ __forceinline__ void prologue_phase(karg_t kp, LAS unsigned char* lds, int vcu, int G) {
    int tid_ = threadIdx.x; asm volatile("" : "+v"(tid_));
    const int tid = tid_, lane = tid & 63, wave = __builtin_amdgcn_readfirstlane(tid >> 6);
    unsigned char* ws = KWS;
    LAS float* scr = (LAS float*)(lds + wave * 16384);
    const int gw = vcu * NWAVES + wave, NGW = G * NWAVES;
#if PROBE
    if (blockIdx.x == 0 && tid == 0) ((unsigned long long*)ws)[100] = __builtin_amdgcn_s_memrealtime();
#endif
    for (int m = gw; m < NMEMROWS; m += NGW) {
        const float* src = (m < 4096) ? KIN(2) + (size_t)m * D : KIN(3) + (size_t)(m - 4096) * D;
        f32x4 v[4]; float s = 0.f;
#pragma unroll
        for (int j = 0; j < 4; ++j) { v[j] = *((const f32x4*)src + lane + 64 * j); s += (v[j][0] * v[j][0] + v[j][1] * v[j][1]) + (v[j][2] * v[j][2] + v[j][3] * v[j][3]); }
        s = wave_sum(s);
        u32x2* o8 = (u32x2*)((bf16_t*)(ws + WS_MB) + (size_t)m * D) + lane;
#pragma unroll
        for (int j = 0; j < 4; ++j) { u32x2 w; w.x = pk_bf16(v[j][0], v[j][1]); w.y = pk_bf16(v[j][2], v[j][3]); o8[64 * j] = w; }
        if (lane < 4) ((float*)(ws + WS_SSPM))[(size_t)m * 4 + lane] = (lane == 0) ? s : 0.f;
    }
    { float* rc = (float*)(ws + WS_ROPE); float* rsn = rc + SEQS * 32;
      for (int idx = (vcu * NTHR + tid); idx < SEQS * 32; idx += G * NTHR) {
          const int pos = idx >> 5, i = idx & 31;
          const float invf = exp2f(-(float)(2 * i) * (13.287712379549449f / 64.0f));
          const float ang = (float)pos * invf;
          const double rev = (double)ang * 0.15915494309189535; const float fr = (float)(rev - floor(rev));
          rc[idx] = __builtin_amdgcn_cosf(fr); rsn[idx] = __builtin_amdgcn_sinf(fr); } }
#if PROBE
    if (blockIdx.x == 0 && tid == 0) ((unsigned long long*)ws)[101] = __builtin_amdgcn_s_memrealtime();
#endif
    constexpr int I_PW = 4 * 8, I_QKV = 16 * 48, I_DD = 16 * 32, I_KV = 16 * 64, I_UP = 16 * 128, I_DN = 64 * 32;
    constexpr int NITEMS = 4 * I_PW + I_QKV + I_DD + 2 * I_DD + 2 * I_KV + 2 * I_DD + 2 * I_UP + 2 * I_DN;
    for (int it = gw; it < NITEMS; it += NGW) {
        int r = it;
        if (r < 2 * I_UP) { const int L = r / I_UP; p0_transpose_item(KIN(16) + (size_t)L * D * FF, D, FF, (bf16_t*)(ws + WS_WUP) + (size_t)L * D * FF, KIN(15) + L * D, 0, scr, r % I_UP, lane); continue; } r -= 2 * I_UP;
        if (r < 2 * I_DN) { const int L = r / I_DN; p0_transpose_item(KIN(17) + (size_t)L * D * FF, FF, D, (bf16_t*)(ws + WS_WDN) + (size_t)L * D * FF, nullptr, 0, scr, r % I_DN, lane); continue; } r -= 2 * I_DN;
        if (r < 2 * I_KV) { const int L = r / I_KV; p0_transpose_item(KIN(13) + (size_t)L * D * 2 * D, D, 2 * D, (bf16_t*)(ws + WS_WXKV) + (size_t)L * D * 2 * D, KIN(11) + L * D, 0, scr, r % I_KV, lane); continue; } r -= 2 * I_KV;
        if (r < I_QKV) { p0_transpose_item(KIN(7), D, NQKV, (bf16_t*)(ws + WS_WQKV), KIN(4) + D, 1280, scr, r, lane); continue; } r -= I_QKV;
        if (r < I_DD) { p0_transpose_item(KIN(8), D, D, (bf16_t*)(ws + WS_WAO), nullptr, 0, scr, r, lane); continue; } r -= I_DD;
        if (r < 2 * I_DD) { const int L = r / I_DD; p0_transpose_item(KIN(12) + (size_t)L * D * D, D, D, (bf16_t*)(ws + WS_WXQ) + (size_t)L * D * D, KIN(10) + L * D, 0, scr, r % I_DD, lane); continue; } r -= 2 * I_DD;
        if (r < 2 * I_DD) { const int L = r / I_DD; p0_transpose_item(KIN(14) + (size_t)L * D * D, D, D, (bf16_t*)(ws + WS_WXO) + (size_t)L * D * D, nullptr, 0, scr, r % I_DD, lane); continue; } r -= 2 * I_DD;
        { const int gI = r / I_PW; p0_transpose_item(KIN(5) + (size_t)gI * 65536, 256, 256, (bf16_t*)(ws + WS_PW) + (size_t)gI * 65536, nullptr, 0, scr, r % I_PW, lane); }
    }
}

__device__ __forceinline__ void pool_phase(karg_t kp, LAS unsigned char* lds, int vcu, int G) {
    int tid_ = threadIdx.x; asm volatile("" : "+v"(tid_));
    const int tid = tid_, lane = tid & 63, wave = __builtin_amdgcn_readfirstlane(tid >> 6);
    bf16_t* diff = (bf16_t*)(KWS + WS_QB);
    const float* x0 = KIN(0); const float* x1 = KIN(1); const float* gmix = KIN(4);
    constexpr int NU = T / 32;
    f32x4 gm[4];
#pragma unroll
    for (int j = 0; j < 4; ++j) gm[j] = *((const f32x4*)gmix + lane + 64 * j);
    f32x4 pv[6][4];
#define POOL_FETCH(u) do { const int t0_ = (u) * 32; \
        const int s0_ = t0_ < TP ? (t0_ & ~(SEQP - 1)) : (t0_ & ~(SEQS - 1)), s1_ = s0_ + (t0_ < TP ? SEQP : SEQS); \
        _Pragma("unroll") for (int q = 0; q < 6; ++q) { const int grow = t0_ - 8 + wave * 6 + q; \
            if (grow >= s0_ && grow < s1_) { const float* src = (grow < TP) ? x0 + (size_t)grow * D : x1 + (size_t)(grow - TP) * D; \
                _Pragma("unroll") for (int j = 0; j < 4; ++j) pv[q][j] = *((const f32x4*)src + lane + 64 * j); } \
            else { _Pragma("unroll") for (int j = 0; j < 4; ++j) pv[q][j] = (f32x4){0.f, 0.f, 0.f, 0.f}; } } } while (0)
    if (vcu < NU) POOL_FETCH(vcu);
    __syncthreads();
    for (int u = vcu; u < NU; u += G) {
        const int t0 = u * 32;
        const int s0 = t0 < TP ? (t0 & ~(SEQP - 1)) : (t0 & ~(SEQS - 1)), s1 = s0 + (t0 < TP ? SEQP : SEQS);
#pragma unroll
        for (int q = 0; q < 6; ++q) {
            float ss = 0.f;
#pragma unroll
            for (int j = 0; j < 4; ++j) ss += (pv[q][j][0] * pv[q][j][0] + pv[q][j][1] * pv[q][j][1]) + (pv[q][j][2] * pv[q][j][2] + pv[q][j][3] * pv[q][j][3]);
            const float rs = rsqrtf(wave_sum(ss) * (1.0f / D) + EPS);
#pragma unroll
            for (int j = 0; j < 4; ++j) { const f32x4 h = pv[q][j] * rs * gm[j]; u32x2 w; w.x = pk_bf16(h[0], h[1]); w.y = pk_bf16(h[2], h[3]);
                *(LAS u32x2*)(lds + (wave * 6 + q) * 2048 + (lane + 64 * j) * 8) = w; }
        }
        WG_BAR_LDS();
        if (u + G < NU) POOL_FETCH(u + G);
        const int c2 = tid * 2, g = tid >> 7, hw = 1 << g;
        const LAS unsigned char* col = lds + c2 * 2;
#define POOL_LD(r) ({ const unsigned w_ = *(const LAS unsigned*)(col + (r) * 2048); (f32x2){__uint_as_float(w_ << 16), __uint_as_float(w_ & 0xffff0000u)}; })
        f32x2 sum = (f32x2){0.f, 0.f};
        for (int j = -hw; j < hw; ++j) sum += POOL_LD(8 + j);
        for (int r = 0; r < 32; ++r) {
            const int t = t0 + r;
            const int lo = max(t - hw, s0), hi2 = min(t + hw, s1);
            const f32x2 ctr = POOL_LD(r + 8);
            const float ic = 1.0f / (float)(hi2 - lo);
            *(unsigned*)(diff + (size_t)t * D + c2) = pk_bf16(sum[0] * ic - ctr[0], sum[1] * ic - ctr[1]);
            if (r < 31) sum += POOL_LD(r + 8 + hw) - POOL_LD(r + 8 - hw);
        }
        WG_BAR_LDS();
    }
#undef POOL_FETCH
#undef POOL_LD
}

__device__ __forceinline__ void final_phase(karg_t kp, int vcu, int G) {
    int tid_ = threadIdx.x; asm volatile("" : "+v"(tid_));
    const int tid = tid_, lane = tid & 63, wave = __builtin_amdgcn_readfirstlane(tid >> 6);
    const int gw = vcu * NWAVES + wave, NGW = G * NWAVES;
    const bf16_t* XB = (const bf16_t*)(KWS + WS_XB);
    f32x4 gn[4];
#pragma unroll
    for (int j = 0; j < 4; ++j) gn[j] = *((const f32x4*)KIN(18) + lane + 64 * j);
    for (int m = gw; m < T; m += 2 * NGW) {
        u32x2 w[2][4];
#pragma unroll
        for (int q = 0; q < 2; ++q)
#pragma unroll
            for (int j = 0; j < 4; ++j) w[q][j] = *((const u32x2*)(XB + (size_t)(m + q * NGW) * D) + lane + 64 * j);
#pragma unroll
        for (int q = 0; q < 2; ++q) {
            f32x4 v[4]; float s = 0.f;
#pragma unroll
            for (int j = 0; j < 4; ++j) {
                v[j] = (f32x4){__uint_as_float(w[q][j].x << 16), __uint_as_float(w[q][j].x & 0xffff0000u), __uint_as_float(w[q][j].y << 16), __uint_as_float(w[q][j].y & 0xffff0000u)};
                s += (v[j][0] * v[j][0] + v[j][1] * v[j][1]) + (v[j][2] * v[j][2] + v[j][3] * v[j][3]);
            }
            const float rs = rsqrtf(wave_sum(s) * (1.0f / D) + EPS);
            f32x4* row = (f32x4*)(KOUT + (size_t)(m + q * NGW) * D);
#pragma unroll
            for (int j = 0; j < 4; ++j) __builtin_nontemporal_store(v[j] * rs * gn[j], row + lane + 64 * j);
        }
    }
}

#define XB_TMO      128
#define XB_XCNT(j)  (256  + 64 * (j))
#define XB_XSUB(j)  (1280 + 64 * (j))
#define XB_XGEN(j)  (2304 + 64 * (j))
#define XB_TOP      3328
#define XB_TOPGEN   3392
#define XCD_BAR_WORDS 3456
#define XB_SPIN_CAP (1u << 22)
__device__ __forceinline__ unsigned xb_ld(unsigned* p)              { return __hip_atomic_load(p, __ATOMIC_RELAXED, __HIP_MEMORY_SCOPE_AGENT); }
__device__ __forceinline__ unsigned xb_add(unsigned* p, unsigned v) { return __hip_atomic_fetch_add(p, v, __ATOMIC_RELAXED, __HIP_MEMORY_SCOPE_AGENT); }
__device__ __forceinline__ unsigned xb_xcc_id() { return (unsigned)__builtin_amdgcn_s_getreg((3 << 11) | 20) & 0xFu; }
#define XB_SPIN(cond, bar) do { unsigned _sp = 0; while (cond) { __builtin_amdgcn_s_sleep(1); \
    if ((++_sp & 255u) == 0u) { if (xb_ld(&(bar)[XB_TMO])) break; if (_sp > XB_SPIN_CAP) { atomicAdd(&(bar)[XB_TMO], 1u); break; } } } } while (0)
struct XcdBarrier { unsigned* bar; unsigned x; volatile LAS unsigned* st; };
__device__ __forceinline__ XcdBarrier xcd_barrier_post(unsigned* bar, volatile LAS unsigned* st) {
    XcdBarrier b; b.bar = bar; b.x = xb_xcc_id(); b.st = st;
    if (threadIdx.x == 0) (void)xb_add(&bar[XB_XCNT(b.x)], 1u);
    return b;
}
__device__ __forceinline__ void xcd_barrier_complete(unsigned* bar, unsigned x, unsigned& nloc, unsigned& nx) {
    const unsigned G = gridDim.x * gridDim.y * gridDim.z;
    unsigned sum, cnt, mine, sp = 0u;
    for (;;) {
        sum = 0u; cnt = 0u; mine = 0u;
#pragma unroll
        for (unsigned j = 0; j < 16; ++j) { const unsigned c = xb_ld(&bar[XB_XCNT(j)]); sum += c; cnt += (c > 0u) ? 1u : 0u; mine = (j == x) ? c : mine; }
        if (sum == G) break;
        __builtin_amdgcn_s_sleep(1);
        if ((++sp & 255u) == 0u) { if (xb_ld(&bar[XB_TMO])) break; if (sp > XB_SPIN_CAP) { atomicAdd(&bar[XB_TMO], 1u); break; } }
    }
    nloc = mine > 0u ? mine : 1u; nx = cnt > 0u ? cnt : 1u;
}
__device__ __forceinline__ void xcd_barrier(const XcdBarrier& b) {
    asm volatile("s_waitcnt vmcnt(0)" ::: "memory");
    __syncthreads();
    if (threadIdx.x == 0) {
        unsigned* bar = b.bar;
        __builtin_amdgcn_s_waitcnt(0);
        unsigned nloc = b.st[0], nx = b.st[1];
        if (nloc == 0u) { xcd_barrier_complete(bar, b.x, nloc, nx); b.st[0] = nloc; b.st[1] = nx; }
        const unsigned old = xb_add(&bar[XB_XSUB(b.x)], 1u);
        const unsigned gen = old / nloc;
        if (old + 1u == (gen + 1u) * nloc) {
            __builtin_amdgcn_fence(__ATOMIC_RELEASE, "agent");
            asm volatile("s_waitcnt vmcnt(0)" ::: "memory");
            const unsigned og = xb_add(&bar[XB_TOP], 1u);
            const unsigned tg = og / nx;
            if (og + 1u == (tg + 1u) * nx) xb_add(&bar[XB_TOPGEN], 1u);
            else XB_SPIN(xb_ld(&bar[XB_TOPGEN]) == tg, bar);
            __builtin_amdgcn_fence(__ATOMIC_ACQUIRE, "agent");
            xb_add(&bar[XB_XGEN(b.x)], 1u);
            asm volatile("s_waitcnt vmcnt(0)" ::: "memory");
        } else {
            XB_SPIN(xb_ld(&bar[XB_XGEN(b.x)]) == gen, bar);
            __builtin_amdgcn_fence(__ATOMIC_ACQUIRE, "agent");
            asm volatile("s_waitcnt vmcnt(0)" ::: "memory");
        }
    }
    __syncthreads();
}
constexpr size_t WS_BAR = 16384;
constexpr int LDS_MISC = 131072 + 1024, LDS_RED = 131072 + 4096;

enum { K_PRO = 0, K_POOL, K_G_RESID, K_G_ROW, K_G_UP, K_G_QKV, K_XATT, K_WATT, K_FINAL };
constexpr int NSTEPS = 28;
struct Step {
    int kind, sync;
    pg8::Gemm g;
    const float* base_lo; const float* base_hi; int split_row; int base_f32; const float* cscale;
    bf16_t* out; int ldc; const float* ssp; float cst; int tsplit; bf16_t* vt; int t_pm_stride, t_ld;
    int layer;
};

__device__ __forceinline__ Step make_step(int vs, karg_t kp) {
    unsigned char* ws = KWS;
    const bool partB = (vs == 15); const int st = partB ? 4 : (vs < 15 ? vs : vs - 1);
    Step s; s.kind = K_PRO; s.sync = 1; s.g = pg8::Gemm{nullptr, nullptr, D, D, D, 0, 0, 0, 0};
    s.base_lo = nullptr; s.base_hi = nullptr; s.split_row = 1 << 30; s.base_f32 = 0; s.cscale = nullptr;
    s.out = nullptr; s.ldc = D; s.ssp = (const float*)(ws + WS_SSP); s.cst = 1.f; s.tsplit = 1 << 20; s.vt = nullptr; s.t_pm_stride = 0; s.t_ld = 0; s.layer = 0;
    bf16_t* XB = (bf16_t*)(ws + WS_XB); bf16_t* QB = (bf16_t*)(ws + WS_QB);
    int mlp = -1, xa = -1;
    if (st == 0) { s.kind = K_PRO; s.sync = 0; }
    else if (st == 1) { s.kind = K_POOL; }
    else if (st == 2) { s.kind = K_G_RESID; s.sync = 0; s.g = pg8::Gemm{QB, (const bf16_t*)(ws + WS_PW), D, 256, 256, 256, T / 256, 4, 0};
        s.base_lo = KIN(0); s.base_hi = KIN(1); s.split_row = TP; s.base_f32 = 1; s.cscale = KIN(6); }
    else if (st == 3 || st == 4) { const int L = st - 3; s.kind = K_G_ROW; s.sync = (st == 4); s.layer = L;
        s.g = pg8::Gemm{(const bf16_t*)(ws + WS_MB), (const bf16_t*)(ws + WS_WXKV) + (size_t)L * 2 * D * D, D, D, D, 0, NMEMROWS / 256, 8, 0};
        s.out = (bf16_t*)(ws + WS_KM) + (size_t)L * NMEMROWS * D; s.ldc = D; s.ssp = (const float*)(ws + WS_SSPM); s.cst = 1.f; s.tsplit = 4;
        s.vt = (bf16_t*)(ws + WS_VMT) + (size_t)L * NMEMROWS * D; s.t_pm_stride = D * 256; s.t_ld = 256;
        if (L == 1) { if (partB) { s.g.u_lo = 0; s.g.u_cnt = 128; s.g.c_rot = 128; s.sync = 1; } else { s.g.u_lo = 128; s.g.u_cnt = 16; s.g.c_rot = 144; } } }
    else if (st >= 5 && st <= 7) { xa = st - 5; s.layer = 0; }
    else if (st >= 8 && st <= 13) { mlp = st - 8; s.layer = 0; }
    else if (st == 14) { s.kind = K_G_QKV; s.sync = 0; s.g = pg8::Gemm{XB, (const bf16_t*)(ws + WS_WQKV), D, D, D, 0, T / 256, 6, 0}; }
    else if (st == 15) { s.kind = K_WATT; }
    else if (st == 16) { s.kind = K_G_RESID; s.g = pg8::Gemm{QB, (const bf16_t*)(ws + WS_WAO), D, D, D, 0, T / 256, 4, 0}; }
    else if (st >= 17 && st <= 19) { xa = st - 17; s.layer = 1; }
    else if (st >= 20 && st <= 25) { mlp = st - 20; s.layer = 1; }
    else { s.kind = K_FINAL; s.sync = 0; }
    if (xa == 0) { s.kind = K_G_ROW; s.g = pg8::Gemm{XB, (const bf16_t*)(ws + WS_WXQ) + (size_t)s.layer * D * D, D, D, D, 0, T / 256, 4, 0};
        s.out = QB; s.ldc = D; s.cst = 0.0625f * LOG2E; s.sync = 0; }
    else if (xa == 1) { s.kind = K_XATT; }
    else if (xa == 2) { s.kind = K_G_RESID; s.g = pg8::Gemm{QB, (const bf16_t*)(ws + WS_WXO) + (size_t)s.layer * D * D, D, D, D, 0, T / 256, 4, 0}; }
    if (mlp >= 0) {
        const int c = mlp >> 1, pm0 = 64 * c;
        bf16_t* H = (bf16_t*)(ws + ((c & 1) ? WS_H1 : WS_H0)) - (size_t)pm0 * 256 * FF;
        if ((mlp & 1) == 0) { s.kind = K_G_UP; s.sync = 1; s.g = pg8::Gemm{XB, (const bf16_t*)(ws + WS_WUP) + (size_t)s.layer * D * FF, D, D, D, 0, 64, 16, pm0}; s.out = H; }
        else { s.kind = K_G_RESID; s.sync = (c == 2); s.g = pg8::Gemm{H, (const bf16_t*)(ws + WS_WDN) + (size_t)s.layer * D * FF, FF, FF, FF, 0, 64, 4, pm0}; }
    }
    return s;
}

__global__ void __launch_bounds__(NTHR, 2) fwd_megakernel(Args a) {
    __builtin_assume(__builtin_amdgcn_workitem_id_y() == 0); __builtin_assume(__builtin_amdgcn_workitem_id_z() == 0);
    extern __shared__ __attribute__((aligned(16))) unsigned char lds_raw[];
    LAS unsigned char* lds = (LAS unsigned char*)lds_raw;
    karg_t kp = (karg_t)__builtin_amdgcn_kernarg_segment_ptr();
    const int G = gridDim.x, bx = blockIdx.x;
    const int vcu = (G % 8 == 0) ? (bx % 8) * (G / 8) + bx / 8 : bx;
    unsigned char* ws = KWS;
    volatile LAS unsigned* misc = (volatile LAS unsigned*)(lds + LDS_MISC);
    if (threadIdx.x < 2) misc[threadIdx.x] = 0u;
    __syncthreads();
    XcdBarrier bar = xcd_barrier_post((unsigned*)(ws + WS_BAR), misc);
#if PROBE
    unsigned long long* tsb = (unsigned long long*)ws;
#endif
    for (int st = a.lo; st < a.hi; ++st) {
        asm volatile("" : "+s"(kp));
        const Step s = make_step(st, kp);
#if PROBE
        if (bx == 0 && threadIdx.x == 0) tsb[2 * st] = __builtin_amdgcn_s_memrealtime();
#endif
        switch (s.kind) {
        case K_PRO: prologue_phase(kp, lds, vcu, G); break;
        case K_POOL: pool_phase(kp, lds, vcu, G); break;
        case K_G_RESID: { pg8::EpiResid E{s.base_lo, s.base_hi, s.split_row, s.base_f32, (bf16_t*)(ws + WS_XB), (float*)(ws + WS_SSP), s.cscale, (LAS float*)(lds + LDS_RED)};
            pg8::gemm_phase<pg8::EpiResid>(lds, s.g, G, bx, E); } break;
        case K_G_ROW: { pg8::EpiRowScale E{s.out, s.ldc, s.ssp, s.cst, s.tsplit, s.vt, s.t_pm_stride, s.t_ld};
            pg8::gemm_phase<pg8::EpiRowScale>(lds, s.g, G, bx, E); } break;
        case K_G_UP: { pg8::EpiUp E{s.out, s.ssp};
            pg8::gemm_phase<pg8::EpiUp>(lds, s.g, G, bx, E); } break;
        case K_G_QKV: { pg8::EpiQKV E{(bf16_t*)(ws + WS_QB), (bf16_t*)(ws + WS_KW), (bf16_t*)(ws + WS_VT), (const float*)(ws + WS_SSP), (const float*)(ws + WS_ROPE), (const float*)(ws + WS_ROPE) + SEQS * 32};
            pg8::gemm_phase<pg8::EpiQKV>(lds, s.g, G, bx, E); } break;
        case K_XATT: {
            const bf16_t* KM = (const bf16_t*)(ws + WS_KM) + (size_t)s.layer * NMEMROWS * D; const bf16_t* VMT = (const bf16_t*)(ws + WS_VMT) + (size_t)s.layer * NMEMROWS * D;
            __builtin_amdgcn_fence(__ATOMIC_ACQUIRE, "agent");
            pg8::Gemm gq{nullptr, nullptr, D, D, D, 0, T / 256, 4, 0};
            pg8::Order S; S.init(gq, G, bx);
            pg8::Unit u;
            for (int i = 0; S.next(i, u); ++i) xattn_unit(lds, (bf16_t*)(ws + WS_QB), KM, VMT, u.pm, u.pn);
        } break;
        case K_WATT: {
            wattn_phase(lds, (bf16_t*)(ws + WS_QB), (const bf16_t*)(ws + WS_KW), (const bf16_t*)(ws + WS_VT), KIN(9), vcu, G);
        } break;
        default: final_phase(kp, vcu, G); break;
        }
#if PROBE
        __syncthreads();
        if (bx == 0 && threadIdx.x == 0) tsb[2 * st + 1] = __builtin_amdgcn_s_memrealtime();
#endif
        if (s.sync && st + 1 < a.hi) { if (a.hi < 0) cg::this_grid().sync(); else xcd_barrier(bar); }
    }
#if PROBE
    cg::this_grid().sync();
    if (bx == 0 && threadIdx.x == 0) {
        const unsigned long long tend = __builtin_amdgcn_s_memrealtime();
        unsigned long long sa = 0, sa2 = 0, sb = 0;
        for (int st = 0; st < NSTEPS; ++st) {
            const unsigned long long w = tsb[2 * st + 1] - tsb[2 * st], y = (st + 1 < NSTEPS ? tsb[2 * st + 2] : tend) - tsb[2 * st + 1];
            if ((P_A1W >> st) & 1ull) sa += w; if ((P_A2W >> st) & 1ull) sa2 += w; if ((P_A1S >> st) & 1ull) sa += y; if ((P_A2S >> st) & 1ull) sa2 += y;
            if ((P_BW >> st) & 1ull) sb += w; if ((P_BS >> st) & 1ull) sb += y;
        }
#if PROBE_SET == 9
        sa = tsb[100] - tsb[0]; sa2 = tsb[101] - tsb[100];
#endif
#if PROBE_SET == 13
        sa = tsb[2 * (NSTEPS - 1) + 1] - tsb[0]; sa2 = 0;
#endif
        const float ta = (float)sa * 0.01f, ta2 = (float)sa2 * 0.01f;
        KOUT[0] += sqrtf(ta * 2.5e-8f * 33554432.f); KOUT[(size_t)TP * D] += sqrtf(ta * 2.5e-8f * 16777216.f);
        KOUT[1] += sqrtf(ta2 * 2.5e-8f * 33554432.f); KOUT[(size_t)TP * D + 1] += sqrtf(ta2 * 2.5e-8f * 16777216.f);
        const unsigned long long t0 = __builtin_amdgcn_s_memrealtime();
        while (__builtin_amdgcn_s_memrealtime() - t0 < sb) __builtin_amdgcn_s_sleep(8);
    }
#endif
}

constexpr int LDS_BYTES = 147456;
extern "C" void kernel_launch(void* const* d_in, const int* in_sizes, int n_in, void* d_out, int out_size, void* d_ws, size_t ws_size, hipStream_t stream) {
    static int grid = 0;
    if (grid == 0) {
        if (n_in != 19 || out_size != T * D || ws_size < WS_END) { fprintf(stderr, "kernel_launch: unexpected problem (n_in %d, out %d, ws %zu); nothing launched\n", n_in, out_size, ws_size); grid = -1; return; }
        int dev = 0, cus = 0, per_cu = 0;
        hipGetDevice(&dev); hipDeviceGetAttribute(&cus, hipDeviceAttributeMultiprocessorCount, dev);
        if (hipFuncSetAttribute((const void*)fwd_megakernel, hipFuncAttributeMaxDynamicSharedMemorySize, LDS_BYTES) != hipSuccess) { fprintf(stderr, "kernel_launch: hipFuncSetAttribute failed\n"); grid = -1; return; }
        if (hipOccupancyMaxActiveBlocksPerMultiprocessor(&per_cu, (const void*)fwd_megakernel, NTHR, LDS_BYTES) != hipSuccess || per_cu < 1) { fprintf(stderr, "kernel_launch: occupancy query says %d\n", per_cu); per_cu = 1; }
        (void)hipGetLastError();
        grid = cus * per_cu;
        fprintf(stderr, "kernel_launch: grid %d (%d CUs x %d)\n", grid, cus, per_cu);
    }
    if (grid < 0) return;
    if (hipMemsetAsync(d_ws, 0, 65536, stream) != hipSuccess) { fprintf(stderr, "kernel_launch: memset failed\n"); return; }
    Args a{};
    for (int i = 0; i < 19; ++i) a.in[i] = (const float*)d_in[i];
    a.out = (float*)d_out; a.ws = (unsigned char*)d_ws;
#if ONE_LAUNCH
    a.lo = 0; a.hi = NSTEPS;
    void* args[] = {&a};
    hipError_t e = hipLaunchCooperativeKernel((const void*)fwd_megakernel, dim3(grid), dim3(NTHR), args, LDS_BYTES, stream);
    if (e != hipSuccess) fprintf(stderr, "kernel_launch: cooperative launch failed: %s (grid %d)\n", hipGetErrorString(e), grid);
#else
    for (int st = 0; st < NSTEPS; ++st) {
        a.lo = st; a.hi = st + 1;
        hipLaunchKernelGGL(fwd_megakernel, dim3(grid), dim3(NTHR), LDS_BYTES, stream, a);
    }
#endif
}
```

```cpp
#include <hip/hip_runtime.h>
#include <hip/hip_cooperative_groups.h>
#include <cstdio>
#include <cstdint>
namespace cg = cooperative_groups;

#ifndef ONE_LAUNCH
#define ONE_LAUNCH 1
#endif
#ifndef PROBE
#define PROBE 0
#endif
#define M_GEMM ((1ull<<2)|(1ull<<3)|(1ull<<4)|(1ull<<5)|(1ull<<7)|(0x3full<<8)|(1ull<<14)|(1ull<<16)|(1ull<<17)|(1ull<<19)|(0x3full<<20))
#define M_ATT ((1ull<<6)|(1ull<<15)|(1ull<<18))
#define M_ELEM ((1ull<<0)|(1ull<<1)|(1ull<<26))
#define M_ALL ((1ull<<27)-1)
#ifndef PROBE_SET
#define PROBE_SET 1
#endif
#define BIT(i) (1ull << (i))
#if PROBE_SET == 1
#define P_A1W BIT(8)
#define P_A2W BIT(9)
#define P_BW 0ull
#define P_BS M_ALL
#elif PROBE_SET == 2
#define P_A1W BIT(15)
#define P_A2W BIT(6)
#define P_BW BIT(0)
#define P_BS 0ull
#elif PROBE_SET == 3
#define P_A1W BIT(7)
#define P_A2W BIT(5)
#define P_BW BIT(1)
#define P_BS 0ull
#elif PROBE_SET == 4
#define P_A1W BIT(14)
#define P_A2W BIT(2)
#define P_BW (BIT(3) | BIT(4))
#define P_BS 0ull
#elif PROBE_SET == 5
#define P_A1W BIT(26)
#define P_A2W BIT(16)
#define P_BW M_GEMM
#define P_BS 0ull
#elif PROBE_SET == 7
#define P_A1W BIT(0)
#define P_A2W 0ull
#define P_A1S 0ull
#define P_A2S BIT(0)
#define P_BW 0ull
#define P_BS BIT(1)
#elif PROBE_SET == 11
#define P_A1W M_GEMM
#define P_A2W 0ull
#define P_A1S 0ull
#define P_A2S M_ALL
#define P_BW M_ATT
#define P_BS 0ull
#elif PROBE_SET == 12
#define P_A1W BIT(0)
#define P_A2W BIT(1)
#define P_BW BIT(26)
#define P_BS 0ull
#elif PROBE_SET == 13
#define P_A1W 0ull
#define P_A2W 0ull
#define P_BW 0ull
#define P_BS 0ull
#elif PROBE_SET == 10
#define P_A1W BIT(9)
#define P_A2W BIT(13)
#define P_BW BIT(8)
#define P_BS 0ull
#elif PROBE_SET == 9
#define P_A1W 0ull
#define P_A2W 0ull
#define P_BW BIT(1)
#define P_BS BIT(1)
#elif PROBE_SET == 8
#define P_A1W BIT(1)
#define P_A2W 0ull
#define P_A1S 0ull
#define P_A2S BIT(4)
#define P_BW 0ull
#define P_BS (BIT(5)|BIT(7)|BIT(14)|BIT(16)|BIT(17)|BIT(19))
#else
#define P_A1W 0ull
#define P_A2W 0ull
#define P_A1S ((0x3full << 8) | (0x3full << 20))
#define P_A2S (BIT(6) | BIT(15) | BIT(18))
#define P_BW 0ull
#define P_BS (BIT(0) | BIT(1) | BIT(4))
#endif
#ifndef P_A1S
#define P_A1S 0ull
#define P_A2S 0ull
#endif

#define LAS __attribute__((address_space(3)))
typedef unsigned short bf16_t;
typedef short bf16x8 __attribute__((ext_vector_type(8)));
typedef float f32x4 __attribute__((ext_vector_type(4)));
typedef float f32x2 __attribute__((ext_vector_type(2)));
typedef float f32x16 __attribute__((ext_vector_type(16)));
typedef unsigned u32x4 __attribute__((ext_vector_type(4)));
typedef unsigned u32x2 __attribute__((ext_vector_type(2)));
typedef __bf16 bf16x2_t __attribute__((ext_vector_type(2)));

constexpr int D = 1024, FF = 4096, T = 49152, TP = 32768, SEQP = 2048, SEQS = 8192, NMEMROWS = 4608, NQKV = 1536;
constexpr float EPS = 1e-6f, LOG2E = 1.4426950408889634f;
constexpr int NWAVES = 8, NTHR = 512;

constexpr size_t MiB = 1u << 20;
constexpr size_t WS_PW = 1 * MiB, WS_WQKV = 2 * MiB, WS_WAO = 5 * MiB, WS_WXQ = 7 * MiB, WS_WXKV = 11 * MiB, WS_WXO = 19 * MiB, WS_WUP = 23 * MiB, WS_WDN = 39 * MiB;
constexpr size_t WS_ROPE = 55 * MiB, WS_RSTD0 = 57 * MiB, WS_SSP = 58 * MiB, WS_SSPM = 61 * MiB, WS_MB = 62 * MiB, WS_KM = 71 * MiB, WS_VMT = 89 * MiB, WS_XB = 108 * MiB;
constexpr size_t WS_BIG = 204 * MiB, WS_QB = WS_BIG, WS_KW = WS_BIG + 96 * MiB, WS_VT = WS_BIG + 120 * MiB, WS_H0 = WS_BIG, WS_H1 = WS_BIG + 128 * MiB, WS_END = WS_BIG + 256 * MiB;

__device__ __forceinline__ unsigned pk_bf16(float lo, float hi) { f32x2 v = {lo, hi}; bf16x2_t b = __builtin_convertvector(v, bf16x2_t); return __builtin_bit_cast(unsigned, b); }
__device__ __forceinline__ float rstd_from(const float* p) {
    const f32x4 s = *(const f32x4*)p;
    return rsqrtf(((s[0] + s[1]) + (s[2] + s[3])) * (1.0f / D) + EPS);
}
__device__ __forceinline__ float wave_sum(float v) {
#pragma unroll
    for (int o = 1; o < 64; o <<= 1) v += __shfl_xor(v, o);
    return v;
}

namespace pg8 {
constexpr int BM = 256, BK = 64, HALF = 128, HTB = HALF * BK * 2, STAGE_BYTES = 8 * HTB, NXCD = 8, WGM = 8;
__host__ __device__ __forceinline__ int lds_byte(int r, int c) { const int st = (r >> 4) * 2 + (c >> 5), rr = r & 15, cc = c & 31, ob = rr * 64 + cc * 2; return st * 1024 + (ob ^ (((ob >> 9) & 1) << 5)); }
__host__ __device__ __forceinline__ void stage_rc(int b, int& R, int& C) { const int st = b / 1024, sb = b % 1024, swz = sb ^ (((sb >> 9) & 1) << 5); R = (st >> 1) * 16 + swz / 64; C = (st & 1) * 32 + (swz % 64) / 2; }
__host__ __device__ __forceinline__ int perm32(int rho) { const int n = rho >> 4, i = rho & 15; return 8 * (i >> 2) + 4 * n + (i & 3); }

struct Unit { int pm, pn; };
struct Gemm { const bf16_t* A; const bf16_t* Bt; int lda, ldb, K, a_pn_off, nM, nN, pm0, u_lo, u_cnt, c_rot; };

struct Order {
    int nM, nN, nwg, G, c, pm0, u_lo, u_cnt;
    __device__ __forceinline__ void init(const Gemm& g, int G_, int c_) { nM = g.nM; nN = g.nN; nwg = nM * nN; G = G_; pm0 = g.pm0; u_lo = g.u_lo; u_cnt = g.u_cnt ? g.u_cnt : nwg;
        const int cc = c_ - g.c_rot; c = cc < 0 ? cc + G_ : cc; }
    __device__ __forceinline__ bool next(int i, Unit& u) const {
        const long L = (long)i * G + c; if (L >= u_cnt) return false;
        int wgid = (int)L + u_lo; { const int q = nwg / NXCD, r = nwg % NXCD, xcd = wgid % NXCD, off = wgid / NXCD; wgid = (xcd < r ? xcd * (q + 1) : r * (q + 1) + (xcd - r) * q) + off; }
        const int nig = WGM * nN, gid = wgid / nig, fm = gid * WGM, gsz = (nM - fm) < WGM ? (nM - fm) : WGM;
        u.pm = fm + ((wgid % nig) % gsz) + pm0; u.pn = (wgid % nig) / gsz; return true;
    }
};

template <class Epi>
__device__ __forceinline__ void gemm_phase(LAS unsigned char* lds, const Gemm g, const int G, const int cblk, const Epi& E) {
    int tid_ = threadIdx.x; asm volatile("" : "+v"(tid_));
    const int tid = tid_, wid = __builtin_amdgcn_readfirstlane(tid >> 6), lane = tid & 63, wr = wid >> 2, wc = wid & 3, fr = lane & 15, fq = lane >> 4;
    const int nt = g.K / BK;
    Order S; S.init(g, G, cblk);
    unsigned voffA[2], voffB[2];
#pragma unroll
    for (int i = 0; i < 2; ++i) { int R, C; stage_rc(tid * 16 + i * 8192, R, C); const int Rb = (R & ~31) + perm32(R & 31);
        voffA[i] = (unsigned)(R * g.lda + C) * 2u; voffB[i] = (unsigned)(Rb * g.ldb + C) * 2u; }
    const size_t kstep = (size_t)(BK * 2);
    const size_t hstepA = (size_t)HALF * g.lda * 2, hstepB = (size_t)HALF * g.ldb * 2;
    const unsigned ldsw = (unsigned)wid * 1024u;
    const int aoff = lds_byte(wr * 64 + fr, fq * 8), boff = lds_byte(wc * 32 + fr, fq * 8);
#define PG8_UA(u) ((const char*)g.A + ((size_t)(u).pm * BM * g.lda + (size_t)(u).pn * g.a_pn_off) * 2)
#define PG8_UB(u) ((const char*)g.Bt + (size_t)(u).pn * BM * g.ldb * 2)
#define PG8_SA(b, h) (((b) * 2 + (h)) * HTB)
#define PG8_SB(b, h) ((4 + (b) * 2 + (h)) * HTB)
#define PG8_STAGE(bufoff, gbase, voff) do { _Pragma("unroll") for (int _i = 0; _i < 2; ++_i) \
        __builtin_amdgcn_global_load_lds((const unsigned*)((const char*)(gbase) + (voff)[_i]), (LAS unsigned*)(lds + (bufoff) + ldsw + _i * 8192), 16, 0, 0); } while (0)
#define PG8_LDA(dst, b, h) do { _Pragma("unroll") for (int m = 0; m < 4; ++m) _Pragma("unroll") for (int k = 0; k < 2; ++k) dst[m][k] = *(const LAS bf16x8*)(lds + PG8_SA(b, h) + aoff + m * 2048 + k * 1024); } while (0)
#define PG8_LDB(dst, b, h) do { _Pragma("unroll") for (int n = 0; n < 2; ++n) _Pragma("unroll") for (int k = 0; k < 2; ++k) dst[n][k] = *(const LAS bf16x8*)(lds + PG8_SB(b, h) + boff + n * 2048 + k * 1024); } while (0)
#define PG8_MMA(ai, bj, At, Bt) do { __builtin_amdgcn_s_setprio(1); _Pragma("unroll") for (int m = 0; m < 4; ++m) _Pragma("unroll") for (int n = 0; n < 2; ++n) _Pragma("unroll") for (int k = 0; k < 2; ++k) \
        acc[ai][bj][m][n] = __builtin_amdgcn_mfma_f32_16x16x32_bf16(Bt[n][k], At[m][k], acc[ai][bj][m][n], 0, 0, 0); __builtin_amdgcn_s_setprio(0); } while (0)
#define PG8_WAIT_V(n) asm volatile("s_waitcnt vmcnt(" #n ")" ::: "memory")
#define PG8_WAIT_L(n) asm volatile("s_waitcnt lgkmcnt(" #n ")" ::: "memory")
#define PG8_BAR __builtin_amdgcn_s_barrier()
#define PG8_SCHED __builtin_amdgcn_sched_barrier(0)
    Unit cur, nxt; int ui = 0;
    if (!S.next(0, cur)) return;
    f32x4 acc[2][2][4][2];
#pragma unroll
    for (int a = 0; a < 2; ++a)
#pragma unroll
        for (int b = 0; b < 2; ++b)
#pragma unroll
            for (int m = 0; m < 4; ++m)
#pragma unroll
                for (int n = 0; n < 2; ++n) acc[a][b][m][n] = (f32x4){0.f, 0.f, 0.f, 0.f};
    bf16x8 At[4][2], B0[2][2], B1[2][2];
    const char* cA = PG8_UA(cur); const char* cB = PG8_UB(cur);
    PG8_STAGE(PG8_SB(0, 0), cB, voffB); PG8_STAGE(PG8_SB(0, 1), cB + hstepB, voffB); PG8_STAGE(PG8_SA(0, 0), cA, voffA); PG8_STAGE(PG8_SA(0, 1), cA + hstepA, voffA);
    if (E.ssp_rows()) {
        LAS float* tab = (LAS float*)(lds + STAGE_BYTES + 8192);
        Unit uu;
        for (int i = 0; i < 8 && S.next(i, uu); ++i) { if (tid < 256) tab[i * 256 + tid] = rstd_from(E.ssp_rows() + (size_t)(uu.pm * BM + tid) * 4); }
        asm volatile("s_waitcnt lgkmcnt(0)" ::: "memory");
    }
    if (wr == 1) PG8_BAR;
    PG8_WAIT_V(2); PG8_BAR;
    PG8_STAGE(PG8_SB(1, 0), cB + kstep, voffB); PG8_STAGE(PG8_SA(1, 0), cA + kstep, voffA); PG8_STAGE(PG8_SB(1, 1), cB + hstepB + kstep, voffB);
    PG8_WAIT_V(6); PG8_BAR;
    for (;;) {
        const bool has_next = S.next(ui + 1, nxt);
        const char* nA = has_next ? PG8_UA(nxt) : cA; const char* nB = has_next ? PG8_UB(nxt) : cB;
        for (int t = 0; t < nt; t += 2) {
            const bool last = (t == nt - 2);
            const char* a1 = cA + (size_t)(t + 1) * kstep;
            const char* a2 = last ? nA : cA + (size_t)(t + 2) * kstep; const char* b2 = last ? nB : cB + (size_t)(t + 2) * kstep;
            const char* a3 = a2 + kstep; const char* b3 = b2 + kstep;
            PG8_LDB(B0, 0, 0); PG8_LDB(B1, 0, 1); PG8_SCHED; PG8_LDA(At, 0, 0); PG8_STAGE(PG8_SA(1, 1), a1 + hstepA, voffA);
            PG8_WAIT_V(8); PG8_WAIT_L(0); PG8_BAR; PG8_MMA(0, 0, At, B0); PG8_MMA(0, 1, At, B1); PG8_BAR; PG8_SCHED;
            PG8_LDA(At, 0, 1); PG8_STAGE(PG8_SB(0, 0), b2, voffB); PG8_STAGE(PG8_SB(0, 1), b2 + hstepB, voffB); PG8_STAGE(PG8_SA(0, 0), a2, voffA);
            PG8_WAIT_V(8); PG8_WAIT_L(0); PG8_BAR; PG8_MMA(1, 0, At, B0); PG8_MMA(1, 1, At, B1); PG8_BAR; PG8_SCHED;
            PG8_LDB(B0, 1, 0); PG8_LDB(B1, 1, 1); PG8_SCHED; PG8_LDA(At, 1, 0); PG8_STAGE(PG8_SA(0, 1), a2 + hstepA, voffA);
            PG8_WAIT_V(8); PG8_WAIT_L(0); PG8_BAR; PG8_MMA(0, 0, At, B0); PG8_MMA(0, 1, At, B1); PG8_BAR; PG8_SCHED;
            PG8_LDA(At, 1, 1); PG8_STAGE(PG8_SB(1, 0), b3, voffB); PG8_STAGE(PG8_SB(1, 1), b3 + hstepB, voffB); PG8_STAGE(PG8_SA(1, 0), a3, voffA);
            PG8_WAIT_V(8); PG8_WAIT_L(0); PG8_BAR; PG8_MMA(1, 0, At, B0); PG8_MMA(1, 1, At, B1); PG8_BAR; PG8_SCHED;
        }
        if (wr == 0) PG8_BAR;
        E(acc, cur, wr, wc, fr, fq, (const LAS float*)(lds + STAGE_BYTES + 8192) + (ui & 7) * 256);
        if (!has_next) break;
#pragma unroll
        for (int a = 0; a < 2; ++a)
#pragma unroll
            for (int b = 0; b < 2; ++b)
#pragma unroll
                for (int m = 0; m < 4; ++m)
#pragma unroll
                    for (int n = 0; n < 2; ++n) acc[a][b][m][n] = (f32x4){0.f, 0.f, 0.f, 0.f};
        cur = nxt; cA = nA; cB = nB; ++ui;
        if (wr == 1) PG8_BAR;
    }
    PG8_WAIT_V(0);
    PG8_BAR;
#undef PG8_UA
#undef PG8_UB
#undef PG8_SA
#undef PG8_SB
#undef PG8_STAGE
#undef PG8_LDA
#undef PG8_LDB
#undef PG8_MMA
#undef PG8_WAIT_V
#undef PG8_WAIT_L
#undef PG8_BAR
#undef PG8_SCHED
}

struct EpiResid {
    const float* base_lo; const float* base_hi; int split_row; int base_f32;
    bf16_t* xb; float* ssp; const float* cscale; LAS float* red;
    __device__ __forceinline__ const float* ssp_rows() const { return nullptr; }
    __device__ __forceinline__ void operator()(const f32x4 (&acc)[2][2][4][2], const Unit& u, int wr, int wc, int fr, int fq, const LAS float* rstab) const {
        const int rl0 = wr * 64 + fr, col0 = u.pn * BM + wc * 32 + 8 * fq;
        f32x4 cs[2][2];
#pragma unroll
        for (int bj = 0; bj < 2; ++bj)
#pragma unroll
            for (int n = 0; n < 2; ++n) cs[bj][n] = cscale ? *(const f32x4*)(cscale + col0 + bj * HALF + 4 * n) : (f32x4){1.f, 1.f, 1.f, 1.f};
        const float* bp = (u.pm * BM < split_row) ? base_lo : (base_hi - (size_t)split_row * D);
#define RESID_BODY(m_, bj_, b0_, b1_) do { \
            const f32x4 v0 = (b0_) + acc[ai][bj_][m_][0] * cs[bj_][0], v1 = (b1_) + acc[ai][bj_][m_][1] * cs[bj_][1]; \
            ssr[m_] += (v0[0] * v0[0] + v0[1] * v0[1]) + (v0[2] * v0[2] + v0[3] * v0[3]) + (v1[0] * v1[0] + v1[1] * v1[1]) + (v1[2] * v1[2] + v1[3] * v1[3]); \
            u32x4 w; w.x = pk_bf16(v0[0], v0[1]); w.y = pk_bf16(v0[2], v0[3]); w.z = pk_bf16(v1[0], v1[1]); w.w = pk_bf16(v1[2], v1[3]); \
            *(u32x4*)(xb + offa + (size_t)(m_) * 16 * D + (bj_) * HALF) = w; } while (0)
#pragma unroll
        for (int ai = 0; ai < 2; ++ai) {
            int rla = rl0 + ai * HALF; asm volatile("" : "+v"(rla) :: "memory");
            const size_t offa = (size_t)(u.pm * BM + rla) * D + col0;
            float ssr[4] = {0.f, 0.f, 0.f, 0.f};
            if (!base_f32) {
                u32x4 pre[4][2];
#pragma unroll
                for (int m = 0; m < 4; ++m)
#pragma unroll
                    for (int bj = 0; bj < 2; ++bj) pre[m][bj] = *(const u32x4*)(xb + offa + (size_t)m * 16 * D + bj * HALF);
#pragma unroll
                for (int m = 0; m < 4; ++m)
#pragma unroll
                    for (int bj = 0; bj < 2; ++bj) { const u32x4 w0 = pre[m][bj];
                        const f32x4 b0 = (f32x4){__uint_as_float(w0.x << 16), __uint_as_float(w0.x & 0xffff0000u), __uint_as_float(w0.y << 16), __uint_as_float(w0.y & 0xffff0000u)};
                        const f32x4 b1 = (f32x4){__uint_as_float(w0.z << 16), __uint_as_float(w0.z & 0xffff0000u), __uint_as_float(w0.w << 16), __uint_as_float(w0.w & 0xffff0000u)};
                        RESID_BODY(m, bj, b0, b1); }
            } else {
#pragma unroll
                for (int mp = 0; mp < 2; ++mp) {
                    f32x4 pf[2][2][2];
#pragma unroll
                    for (int mm = 0; mm < 2; ++mm)
#pragma unroll
                        for (int bj = 0; bj < 2; ++bj) { const float* p = bp + offa + (size_t)(2 * mp + mm) * 16 * D + bj * HALF; pf[mm][bj][0] = *(const f32x4*)p; pf[mm][bj][1] = *(const f32x4*)(p + 4); }
#pragma unroll
                    for (int mm = 0; mm < 2; ++mm)
#pragma unroll
                        for (int bj = 0; bj < 2; ++bj) RESID_BODY(2 * mp + mm, bj, pf[mm][bj][0], pf[mm][bj][1]);
                    asm volatile("" ::: "memory");
                }
            }
#pragma unroll
            for (int m = 0; m < 4; ++m) { float ss = ssr[m]; ss += __shfl_xor(ss, 16); ss += __shfl_xor(ss, 32); if (fq == 0) red[(rla + m * 16) * 4 + wc] = ss; }
        }
#undef RESID_BODY
        asm volatile("s_waitcnt lgkmcnt(0)\n\ts_barrier" ::: "memory");
        const int t = threadIdx.x;
        if (t < 256) { const f32x4 p = *(const LAS f32x4*)(red + t * 4); ssp[(size_t)(u.pm * BM + t) * 4 + u.pn] = (p[0] + p[1]) + (p[2] + p[3]); }
    }
};
struct EpiRowScale {
    bf16_t* out; int ldc; const float* ssp; float cst; int tsplit; bf16_t* vt; int t_pm_stride, t_ld;
    __device__ __forceinline__ const float* ssp_rows() const { return ssp; }
    __device__ __forceinline__ void operator()(const f32x4 (&acc)[2][2][4][2], const Unit& u, int wr, int wc, int fr, int fq, const LAS float* rstab) const {
        const int rl0 = wr * 64 + fr, col0 = u.pn * BM + wc * 32 + 8 * fq;
        const bool tr = u.pn >= tsplit;
        float rs[8];
#pragma unroll
        for (int i = 0; i < 8; ++i) rs[i] = rstab[rl0 + (i >> 2) * HALF + (i & 3) * 16] * cst;
#pragma unroll
        for (int ai = 0; ai < 2; ++ai)
#pragma unroll
            for (int m = 0; m < 4; ++m) {
                int rl = rl0 + ai * HALF + m * 16; asm volatile("" : "+v"(rl) :: "memory");
                const int row = u.pm * BM + rl;
#pragma unroll
                for (int bj = 0; bj < 2; ++bj) {
                    const f32x4 v0 = acc[ai][bj][m][0] * rs[ai * 4 + m], v1 = acc[ai][bj][m][1] * rs[ai * 4 + m];
                    u32x4 w; w.x = pk_bf16(v0[0], v0[1]); w.y = pk_bf16(v0[2], v0[3]); w.z = pk_bf16(v1[0], v1[1]); w.w = pk_bf16(v1[2], v1[3]);
                    if (!tr) *(u32x4*)(out + (size_t)row * ldc + col0 + bj * HALF) = w;
                    else { bf16_t* p = vt + (size_t)u.pm * t_pm_stride + (size_t)(col0 - tsplit * BM + bj * HALF) * t_ld + rl;
                        p[0] = (bf16_t)w.x; p[(size_t)t_ld] = (bf16_t)(w.x >> 16); p[(size_t)2 * t_ld] = (bf16_t)w.y; p[(size_t)3 * t_ld] = (bf16_t)(w.y >> 16);
                        p[(size_t)4 * t_ld] = (bf16_t)w.z; p[(size_t)5 * t_ld] = (bf16_t)(w.z >> 16); p[(size_t)6 * t_ld] = (bf16_t)w.w; p[(size_t)7 * t_ld] = (bf16_t)(w.w >> 16); }
                }
            }
    }
};
struct EpiUp {
    bf16_t* out; const float* ssp;
    __device__ __forceinline__ const float* ssp_rows() const { return ssp; }
    __device__ __forceinline__ void operator()(const f32x4 (&acc)[2][2][4][2], const Unit& u, int wr, int wc, int fr, int fq, const LAS float* rstab) const {
        const int row0 = u.pm * BM + wr * 64 + fr, col0 = u.pn * BM + wc * 32 + 8 * fq;
        float rs[8];
#pragma unroll
        for (int i = 0; i < 8; ++i) rs[i] = rstab[wr * 64 + fr + (i >> 2) * HALF + (i & 3) * 16];
#pragma unroll
        for (int ai = 0; ai < 2; ++ai)
#pragma unroll
            for (int m = 0; m < 4; ++m) {
                int row = row0 + ai * HALF + m * 16; asm volatile("" : "+v"(row) :: "memory");
#pragma unroll
                for (int bj = 0; bj < 2; ++bj) {
                    f32x4 v0 = acc[ai][bj][m][0] * rs[ai * 4 + m], v1 = acc[ai][bj][m][1] * rs[ai * 4 + m];
#pragma unroll
                    for (int e = 0; e < 4; ++e) { v0[e] = fmaxf(v0[e], 0.f); v0[e] *= v0[e]; v1[e] = fmaxf(v1[e], 0.f); v1[e] *= v1[e]; }
                    u32x4 w; w.x = pk_bf16(v0[0], v0[1]); w.y = pk_bf16(v0[2], v0[3]); w.z = pk_bf16(v1[0], v1[1]); w.w = pk_bf16(v1[2], v1[3]);
                    *(u32x4*)(out + (size_t)row * FF + col0 + bj * HALF) = w;
                }
            }
    }
};
struct EpiQKV {
    bf16_t* qb; bf16_t* kw; bf16_t* vt; const float* ssp; const float* ropec; const float* ropes;
    __device__ __forceinline__ const float* ssp_rows() const { return ssp; }
    __device__ __forceinline__ void operator()(const f32x4 (&acc)[2][2][4][2], const Unit& u, int wr, int wc, int fr, int fq, const LAS float* rstab) const {
        const int row0 = u.pm * BM + wr * 64 + fr, colt = wc * 32 + 8 * fq;
        const int dd = 16 * (wc & 1) + 4 * fq;
        float rs[8];
#pragma unroll
        for (int i = 0; i < 8; ++i) rs[i] = rstab[wr * 64 + fr + (i >> 2) * HALF + (i & 3) * 16];
        if (u.pn < 5) {
            const float qs = (u.pn < 4 ? 0.125f * LOG2E : 1.0f);
#pragma unroll
            for (int ai = 0; ai < 2; ++ai) {
                int rowa = row0 + ai * HALF; asm volatile("" : "+v"(rowa) :: "memory");
                f32x4 c[4], sn[4];
#pragma unroll
                for (int m = 0; m < 4; ++m) { const int row = rowa + m * 16; const int pos = row < TP ? (row & (SEQP - 1)) : (row & (SEQS - 1));
                    c[m] = *(const f32x4*)(ropec + pos * 32 + dd); sn[m] = *(const f32x4*)(ropes + pos * 32 + dd); }
#pragma unroll
                for (int m = 0; m < 4; ++m) {
                    const int row = rowa + m * 16; const float sc = rs[ai * 4 + m] * qs;
#pragma unroll
                    for (int bj = 0; bj < 2; ++bj) {
                        const f32x4 x1 = acc[ai][bj][m][0] * sc, x2 = acc[ai][bj][m][1] * sc;
                        const f32x4 o1 = x1 * c[m] - x2 * sn[m], o2 = x2 * c[m] + x1 * sn[m];
                        u32x4 w; w.x = pk_bf16(o1[0], o1[1]); w.y = pk_bf16(o1[2], o1[3]); w.z = pk_bf16(o2[0], o2[1]); w.w = pk_bf16(o2[2], o2[3]);
                        if (u.pn < 4) *(u32x4*)(qb + (size_t)row * D + u.pn * BM + colt + bj * HALF) = w;
                        else *(u32x4*)(kw + (size_t)row * 256 + colt + bj * HALF) = w;
                    }
                }
            }
        } else {
#pragma unroll
            for (int ai = 0; ai < 2; ++ai)
#pragma unroll
                for (int m = 0; m < 4; ++m) {
                    int row = row0 + ai * HALF + m * 16; asm volatile("" : "+v"(row) :: "memory");
#pragma unroll
                    for (int bj = 0; bj < 2; ++bj) {
                        const f32x4 v0 = acc[ai][bj][m][0] * rs[ai * 4 + m], v1 = acc[ai][bj][m][1] * rs[ai * 4 + m];
                        u32x4 w; w.x = pk_bf16(v0[0], v0[1]); w.y = pk_bf16(v0[2], v0[3]); w.z = pk_bf16(v1[0], v1[1]); w.w = pk_bf16(v1[2], v1[3]);
                        bf16_t* p = vt + (size_t)(colt + bj * HALF) * T + row;
                        p[0] = (bf16_t)w.x; p[(size_t)T] = (bf16_t)(w.x >> 16); p[(size_t)2 * T] = (bf16_t)w.y; p[(size_t)3 * T] = (bf16_t)(w.y >> 16);
                        p[(size_t)4 * T] = (bf16_t)w.z; p[(size_t)5 * T] = (bf16_t)(w.z >> 16); p[(size_t)6 * T] = (bf16_t)w.w; p[(size_t)7 * T] = (bf16_t)(w.w >> 16);
                    }
                }
        }
    }
};
}

#define MFMA32(a, b, c) __builtin_amdgcn_mfma_f32_32x32x16_bf16((a), (b), (c), 0, 0, 0)
#define WG_BAR_LDS() asm volatile("s_waitcnt lgkmcnt(0)\n\ts_barrier" ::: "memory")
__device__ __forceinline__ int swap23(int r) { return (r & 0x13) | ((r & 4) << 1) | ((r & 8) >> 1); }
__device__ __forceinline__ bf16x8 pack8(const f32x16& x, int s) {
    u32x4 p; p.x = pk_bf16(x[8 * s + 0], x[8 * s + 1]); p.y = pk_bf16(x[8 * s + 2], x[8 * s + 3]); p.z = pk_bf16(x[8 * s + 4], x[8 * s + 5]); p.w = pk_bf16(x[8 * s + 6], x[8 * s + 7]);
    return __builtin_bit_cast(bf16x8, p);
}
__device__ __forceinline__ float max3(float a, float b, float c) { return __builtin_fmaxf(__builtin_fmaxf(a, b), c); }
__device__ __forceinline__ float vmax16(const f32x16& x) {
    float a = max3(x[0], x[1], x[2]), b = max3(x[3], x[4], x[5]), c = max3(x[6], x[7], x[8]), d = max3(x[9], x[10], x[11]);
    a = max3(a, x[12], x[13]); b = max3(b, x[14], x[15]);
    return __builtin_fmaxf(max3(a, b, c), d);
}

constexpr int XA_KP = 144, XA_VP = 528, XA_BUF = 256 * XA_KP;
__device__ __forceinline__ void xattn_unit(LAS unsigned char* lds, bf16_t* QO, const bf16_t* KM, const bf16_t* VMT, int qt, int h) {
    int tid_ = threadIdx.x; asm volatile("" : "+v"(tid_));
    const int tid = tid_, lane = tid & 63, wid = __builtin_amdgcn_readfirstlane(tid >> 6), r32 = lane & 31, hi = lane >> 5;
    const int seq = qt < 128 ? (qt >> 3) : 16 + ((qt - 128) >> 5);
    const bf16_t* Kg = KM + (size_t)(seq * 256) * D + h * 256;
    const bf16_t* Vg = VMT + ((size_t)seq * D + h * 256) * 256;
    bf16_t* Qg = QO + (size_t)(qt * 256 + wid * 32 + r32) * D + h * 256;
    u32x4 st[4];
#define XA_LOADK(c) do { _Pragma("unroll") for (int i = 0; i < 4; ++i) { const int ch = tid + 512 * i, row = ch >> 3, c16 = ch & 7; st[i] = *(const u32x4*)(Kg + (size_t)row * D + (c) * 64 + c16 * 8); } } while (0)
#define XA_LOADV(c) do { _Pragma("unroll") for (int i = 0; i < 4; ++i) { const int ch = tid + 512 * i, row = ch >> 5, c16 = ch & 31; st[i] = *(const u32x4*)(Vg + (size_t)((c) * 64 + row) * 256 + c16 * 8); } } while (0)
#define XA_WRK(buf) do { _Pragma("unroll") for (int i = 0; i < 4; ++i) { const int ch = tid + 512 * i, row = ch >> 3, c16 = ch & 7; *(LAS u32x4*)(lds + (buf) * XA_BUF + row * XA_KP + c16 * 16) = st[i]; } } while (0)
#define XA_WRV(buf) do { _Pragma("unroll") for (int i = 0; i < 4; ++i) { const int ch = tid + 512 * i, row = ch >> 5, c16 = ch & 31; *(LAS u32x4*)(lds + (buf) * XA_BUF + row * XA_VP + c16 * 16) = st[i]; } } while (0)
    XA_LOADK(0); XA_WRK(0); WG_BAR_LDS();
    f32x16 sc[8];
#pragma unroll
    for (int kb = 0; kb < 8; ++kb)
#pragma unroll
        for (int r = 0; r < 16; ++r) sc[kb][r] = 0.f;
    const int koff = swap23(r32) * XA_KP + hi * 16;
    bf16x8 qf[4];
#pragma unroll
    for (int ds = 0; ds < 4; ++ds) qf[ds] = *(const bf16x8*)(Qg + ds * 16 + hi * 8);
#pragma unroll 1
    for (int c = 0; c < 4; ++c) {
        if (c < 3) XA_LOADK(c + 1); else XA_LOADV(0);
        const LAS unsigned char* kb_base = lds + (c & 1) * XA_BUF + koff;
        {
            bf16x8 kf[2][4];
#pragma unroll
            for (int j = 0; j < 4; ++j) kf[0][j] = *(const LAS bf16x8*)(kb_base + j * 32 * XA_KP);
#pragma unroll
            for (int g = 0; g < 8; ++g) {
                if (g < 7) {
#pragma unroll
                    for (int j = 0; j < 4; ++j) kf[(g + 1) & 1][j] = *(const LAS bf16x8*)(kb_base + (4 * ((g + 1) & 1) + j) * 32 * XA_KP + ((g + 1) >> 1) * 32);
                }
                __builtin_amdgcn_sched_barrier(0);
#pragma unroll
                for (int j = 0; j < 4; ++j) sc[4 * (g & 1) + j] = MFMA32(kf[g & 1][j], qf[g >> 1], sc[4 * (g & 1) + j]);
                __builtin_amdgcn_sched_barrier(0);
            }
        }
        if (c < 3) {
#pragma unroll
            for (int ds = 0; ds < 4; ++ds) qf[ds] = *(const bf16x8*)(Qg + (c + 1) * 64 + ds * 16 + hi * 8);
        }
        if (c < 3) XA_WRK((c + 1) & 1); else XA_WRV(0);
        WG_BAR_LDS();
    }
    float mx = vmax16(sc[0]);
#pragma unroll
    for (int kb = 1; kb < 8; ++kb) mx = fmaxf(mx, vmax16(sc[kb]));
    { const auto rr = __builtin_amdgcn_permlane32_swap(__float_as_uint(mx), __float_as_uint(mx), false, false); mx = fmaxf(__uint_as_float(rr[0]), __uint_as_float(rr[1])); }
    float l = 0.f;
#pragma unroll
    for (int kb = 0; kb < 8; ++kb)
#pragma unroll
        for (int r = 0; r < 16; ++r) { const float p = __builtin_amdgcn_exp2f(sc[kb][r] - mx); sc[kb][r] = p; l += p; }
    { const auto rr = __builtin_amdgcn_permlane32_swap(__float_as_uint(l), __float_as_uint(l), false, false); l = __uint_as_float(rr[0]) + __uint_as_float(rr[1]); }
    const float inv = 1.0f / l;
    bf16x8 pf[16];
#pragma unroll
    for (int kb = 0; kb < 8; ++kb) { pf[2 * kb] = pack8(sc[kb], 0); pf[2 * kb + 1] = pack8(sc[kb], 1); }
    const int voff = r32 * XA_VP + hi * 16;
#pragma unroll 1
    for (int c = 0; c < 4; ++c) {
        if (c < 3) XA_LOADV(c + 1);
        f32x16 o[2];
#pragma unroll
        for (int db = 0; db < 2; ++db)
#pragma unroll
            for (int r = 0; r < 16; ++r) o[db][r] = 0.f;
        const LAS unsigned char* vb_base = lds + (c & 1) * XA_BUF + voff;
        {
            bf16x8 vf[2][4];
#pragma unroll
            for (int j = 0; j < 4; ++j) vf[0][j] = *(const LAS bf16x8*)(vb_base + (j & 1) * 32 * XA_VP + (j >> 1) * 32);
#pragma unroll
            for (int g = 0; g < 8; ++g) {
                if (g < 7) {
#pragma unroll
                    for (int j = 0; j < 4; ++j) vf[(g + 1) & 1][j] = *(const LAS bf16x8*)(vb_base + (j & 1) * 32 * XA_VP + (2 * (g + 1) + (j >> 1)) * 32);
                }
                __builtin_amdgcn_sched_barrier(0);
#pragma unroll
                for (int j = 0; j < 4; ++j) o[j & 1] = MFMA32(vf[g & 1][j], pf[2 * g + (j >> 1)], o[j & 1]);
                __builtin_amdgcn_sched_barrier(0);
            }
        }
#pragma unroll
        for (int db = 0; db < 2; ++db)
#pragma unroll
            for (int gq = 0; gq < 4; ++gq) {
                u32x2 w; w.x = pk_bf16(o[db][4 * gq] * inv, o[db][4 * gq + 1] * inv); w.y = pk_bf16(o[db][4 * gq + 2] * inv, o[db][4 * gq + 3] * inv);
                *(u32x2*)(Qg + c * 64 + db * 32 + gq * 8 + hi * 4) = w;
            }
        if (c < 3) XA_WRV((c + 1) & 1);
        WG_BAR_LDS();
    }
#undef XA_LOADK
#undef XA_LOADV
#undef XA_WRK
#undef XA_WRV
}

constexpr int WA_P = 144, WA_TB = 64 * WA_P;
struct WaUnit { int q0, t_lo, t_hi, hq; };
__device__ __forceinline__ WaUnit wa_unit(int u, int wid) {
    WaUnit w; const int qt = u >> 3; w.hq = 2 * (u & 7) + (wid >> 2);
    w.q0 = qt * 128;
    const int S = w.q0 < TP ? SEQP : SEQS;
    const int q0s = w.q0 < TP ? (w.q0 & (SEQP - 1)) : (w.q0 & (SEQS - 1));
    w.t_lo = (q0s == 0) ? 2 : 0; w.t_hi = (q0s + 128 == S) ? 3 : 5;
    return w;
}
__device__ __forceinline__ void wattn_phase(LAS unsigned char* lds, bf16_t* QO, const bf16_t* KW, const bf16_t* VT, const float* sinks, int vcu, int G) {
    int tid_ = threadIdx.x; asm volatile("" : "+v"(tid_));
    const int tid = tid_, lane = tid & 63, wid = __builtin_amdgcn_readfirstlane(tid >> 6), r32 = lane & 31, hi = lane >> 5;
    constexpr int NU = (T / 128) * 8;
    const int wj = wid & 3, tw_lo = wj >> 1, tw_hi = (wj >> 1) + 4;
    const int srow = tid >> 3, sc16 = tid & 7;
    const int soff = srow * WA_P + sc16 * 16;
    const int koff = swap23(r32) * WA_P + hi * 16, voff = r32 * WA_P + hi * 16;
    const int qrel = wj * 32 + r32;
#define WA_KG(w, t) (KW + (size_t)((w).q0 - 128 + (t) * 64 + srow) * 256 + ((w).hq >> 2) * 64 + sc16 * 8)
#define WA_VG(w, t) (VT + (size_t)(((w).hq >> 2) * 64 + srow) * T + ((w).q0 - 128) + (t) * 64 + sc16 * 8)
#define WA_QG(w) (QO + (size_t)((w).q0 + wj * 32 + r32) * D + (w).hq * 64)
    if (vcu >= NU) return;
    WaUnit w = wa_unit(vcu, wid);
    u32x4 stk = *(const u32x4*)WA_KG(w, w.t_lo), stv = *(const u32x4*)WA_VG(w, w.t_lo);
    bf16x8 qf[4];
#pragma unroll
    for (int ds = 0; ds < 4; ++ds) qf[ds] = *(const bf16x8*)(WA_QG(w) + ds * 16 + hi * 8);
    for (int u = vcu; u < NU; u += G) {
        *(LAS u32x4*)(lds + (w.t_lo & 1) * WA_TB + soff) = stk; *(LAS u32x4*)(lds + (2 + (w.t_lo & 1)) * WA_TB + soff) = stv;
        WG_BAR_LDS();
        const bool has_next = (u + G < NU);
        WaUnit wn = w; if (has_next) wn = wa_unit(u + G, wid);
        bf16x8 qn[4];
#pragma unroll
        for (int ds = 0; ds < 4; ++ds) qn[ds] = qf[ds];
        float mrun = 0.f, l = 0.f;
        f32x16 o[2];
#pragma unroll
        for (int db = 0; db < 2; ++db)
#pragma unroll
            for (int r = 0; r < 16; ++r) o[db][r] = 0.f;
        const int t_first = w.t_lo > tw_lo ? w.t_lo : tw_lo;
#pragma unroll 1
        for (int t = w.t_lo; t <= w.t_hi; ++t) {
            if (t < w.t_hi) { stk = *(const u32x4*)WA_KG(w, t + 1); stv = *(const u32x4*)WA_VG(w, t + 1); }
            else if (has_next) { stk = *(const u32x4*)WA_KG(wn, wn.t_lo); stv = *(const u32x4*)WA_VG(wn, wn.t_lo);
#pragma unroll
                for (int ds = 0; ds < 4; ++ds) qn[ds] = *(const bf16x8*)(WA_QG(wn) + ds * 16 + hi * 8); }
            if (t >= tw_lo && t <= tw_hi) {
                const LAS unsigned char* kb_base = lds + (t & 1) * WA_TB + koff;
                const LAS unsigned char* vb_base = lds + (2 + (t & 1)) * WA_TB + voff;
                f32x16 s[2];
                const float negm = -mrun;
#pragma unroll
                for (int kb = 0; kb < 2; ++kb)
#pragma unroll
                    for (int r = 0; r < 16; ++r) s[kb][r] = negm;
                bf16x8 kf[8], vf[8];
#pragma unroll
                for (int j = 0; j < 8; ++j) kf[j] = *(const LAS bf16x8*)(kb_base + (j & 1) * 32 * WA_P + (j >> 1) * 32);
#pragma unroll
                for (int j = 0; j < 8; ++j) vf[j] = *(const LAS bf16x8*)(vb_base + (j & 1) * 32 * WA_P + (j >> 1) * 32);
                __builtin_amdgcn_sched_barrier(0);
#pragma unroll
                for (int j = 0; j < 8; ++j) s[j & 1] = MFMA32(kf[j], qf[j >> 1], s[j & 1]);
                __builtin_amdgcn_sched_barrier(0);
                const bool full = (64 * t >= wj * 32 + 31) && (64 * t + 63 <= wj * 32 + 256);
                if (!full) {
                    const int kap0 = 64 * t + 8 * hi - qrel;
#pragma unroll
                    for (int kb = 0; kb < 2; ++kb)
#pragma unroll
                        for (int r = 0; r < 16; ++r) { const int dlt = kap0 + 32 * kb + 16 * (r >> 3) + (r & 7); if (dlt < 0 || dlt > 256) s[kb][r] = -1e30f; }
                }
                float mx = __builtin_fmaxf(vmax16(s[0]), vmax16(s[1]));
                { const auto rr = __builtin_amdgcn_permlane32_swap(__float_as_uint(mx), __float_as_uint(mx), false, false);
                  mx = __builtin_fmaxf(__uint_as_float(rr[0]), __uint_as_float(rr[1])); }
                const bool first = (t == t_first);
                if (first || __any(mx > 8.0f)) {
                    const float dl = first ? mx : __builtin_fmaxf(mx, 0.f);
                    mrun += dl;
#pragma unroll
                    for (int kb = 0; kb < 2; ++kb)
#pragma unroll
                        for (int r = 0; r < 16; ++r) s[kb][r] -= dl;
                    if (!first) {
                        const float alpha = __builtin_amdgcn_exp2f(-dl);
                        l *= alpha;
#pragma unroll
                        for (int db = 0; db < 2; ++db)
#pragma unroll
                            for (int r = 0; r < 16; ++r) o[db][r] *= alpha;
                    }
                }
                float ls = 0.f;
#pragma unroll
                for (int kb = 0; kb < 2; ++kb)
#pragma unroll
                    for (int r = 0; r < 16; ++r) { const float p = __builtin_amdgcn_exp2f(s[kb][r]); s[kb][r] = p; ls += p; }
                l += ls;
                bf16x8 pf[4];
                pf[0] = pack8(s[0], 0); pf[1] = pack8(s[0], 1); pf[2] = pack8(s[1], 0); pf[3] = pack8(s[1], 1);
                __builtin_amdgcn_s_setprio(0);
#pragma unroll
                for (int j = 0; j < 8; ++j) o[j & 1] = MFMA32(vf[j], pf[j >> 1], o[j & 1]);
            }
            if (t < w.t_hi) { *(LAS u32x4*)(lds + ((t + 1) & 1) * WA_TB + soff) = stk; *(LAS u32x4*)(lds + (2 + ((t + 1) & 1)) * WA_TB + soff) = stv; }
            WG_BAR_LDS();
        }
        l += __shfl_xor(l, 32);
        l += __builtin_amdgcn_exp2f(sinks[w.hq] * LOG2E - mrun);
        const float inv = 1.0f / l;
        bf16_t* Qg = WA_QG(w);
#pragma unroll
        for (int db = 0; db < 2; ++db)
#pragma unroll
            for (int gq = 0; gq < 4; ++gq) {
                u32x2 ww; ww.x = pk_bf16(o[db][4 * gq] * inv, o[db][4 * gq + 1] * inv); ww.y = pk_bf16(o[db][4 * gq + 2] * inv, o[db][4 * gq + 3] * inv);
                *(u32x2*)(Qg + db * 32 + gq * 8 + hi * 4) = ww;
            }
        w = wn;
#pragma unroll
        for (int ds = 0; ds < 4; ++ds) qf[ds] = qn[ds];
    }
#undef WA_KG
#undef WA_VG
#undef WA_QG
}

__device__ __forceinline__ unsigned f2bf(float f) { return pk_bf16(f, 0.f) & 0xffffu; }
__device__ __forceinline__ void p0_transpose_item(const float* W, int K, int N, bf16_t* WT, const float* gain, int permlim, LAS float* scr, int item, int lane) {
    const int nblk = N / 32, kb = item / nblk, nb = item % nblk, k0 = 64 * kb, n0 = 32 * nb;
    const float* src = W + (size_t)(k0 + (lane >> 5)) * N + n0 + (lane & 31);
    float v[32];
#pragma unroll
    for (int i = 0; i < 32; ++i) v[i] = src[(size_t)(2 * i) * N];
    const int c = lane & 7;
    f32x4 g0 = (f32x4){1.f, 1.f, 1.f, 1.f}, g1 = g0;
    if (gain) { g0 = *(const f32x4*)(gain + k0 + 8 * c); g1 = *(const f32x4*)(gain + k0 + 8 * c + 4); }
#pragma unroll
    for (int i = 0; i < 32; ++i) scr[(2 * i + (lane >> 5)) * 33 + (lane & 31)] = v[i];
    asm volatile("s_waitcnt lgkmcnt(0)" ::: "memory");
#pragma unroll
    for (int j = 0; j < 4; ++j) { const int n = (lane >> 3) + 8 * j; const LAS float* s = scr + (8 * c) * 33 + n;
        u32x4 o; o.x = pk_bf16(s[0 * 33] * g0[0], s[1 * 33] * g0[1]); o.y = pk_bf16(s[2 * 33] * g0[2], s[3 * 33] * g0[3]); o.z = pk_bf16(s[4 * 33] * g1[0], s[5 * 33] * g1[1]); o.w = pk_bf16(s[6 * 33] * g1[2], s[7 * 33] * g1[3]);
        int nn = n0 + n;
        if (nn < permlim) { const int d = nn & 63; const int p = (d < 32) ? (8 * (d >> 2) + (d & 3)) : (8 * ((d - 32) >> 2) + 4 + (d & 3)); nn = (nn & ~63) | p; }
        *(u32x4*)(WT + (size_t)nn * K + k0 + 8 * c) = o; }
    asm volatile("s_waitcnt lgkmcnt(0)" ::: "memory");
}

struct Args { const float* in[19]; float* out; unsigned char* ws; int lo, hi; };
typedef const __attribute__((address_space(4))) unsigned char* karg_t;
typedef const float* cfptr_t;
#define KIN(i) (*(const __attribute__((address_space(4))) cfptr_t*)(kp + 8 * (i)))
#define KOUT (*(float* const __attribute__((address_space(4)))*)(kp + 152))
#define KWS (*(unsigned char* const __attribute__((address_space(4)))*)(kp + 160))

constexpr size_t WS_QCTR = 8192;
__device__ __forceinline__ void prologue_phase(karg_t kp, LAS unsigned char* lds, int vcu, int G) {
    int tid_ = threadIdx.x; asm volatile("" : "+v"(tid_));
    const int tid = tid_, lane = tid & 63, wave = __builtin_amdgcn_readfirstlane(tid >> 6);
    unsigned char* ws = KWS;
    LAS float* scr = (LAS float*)(lds + wave * 16384);
    const int gw = vcu * NWAVES + wave, NGW = G * NWAVES;
#if PROBE
    if (blockIdx.x == 0 && tid == 0) ((unsigned long long*)ws)[100] = __builtin_amdgcn_s_memrealtime();
#endif
    for (int m = gw; m < NMEMROWS; m += NGW) {
        const float* src = (m < 4096) ? KIN(2) + (size_t)m * D : KIN(3) + (size_t)(m - 4096) * D;
        f32x4 v[4]; float s = 0.f;
#pragma unroll
        for (int j = 0; j < 4; ++j) { v[j] = *((const f32x4*)src + lane + 64 * j); s += (v[j][0] * v[j][0] + v[j][1] * v[j][1]) + (v[j][2] * v[j][2] + v[j][3] * v[j][3]); }
        s = wave_sum(s);
        u32x2* o8 = (u32x2*)((bf16_t*)(ws + WS_MB) + (size_t)m * D) + lane;
#pragma unroll
        for (int j = 0; j < 4; ++j) { u32x2 w; w.x = pk_bf16(v[j][0], v[j][1]); w.y = pk_bf16(v[j][2], v[j][3]); o8[64 * j] = w; }
        if (lane < 4) ((float*)(ws + WS_SSPM))[(size_t)m * 4 + lane] = (lane == 0) ? s : 0.f;
    }
    { float* rc = (float*)(ws + WS_ROPE); float* rsn = rc + SEQS * 32;
      for (int idx = (vcu * NTHR + tid); idx < SEQS * 32; idx += G * NTHR) {
          const int pos = idx >> 5, i = idx & 31;
          const float invf = exp2f(-(float)(2 * i) * (13.287712379549449f / 64.0f));
          const float ang = (float)pos * invf;
          const double rev = (double)ang * 0.15915494309189535; const float fr = (float)(rev - floor(rev));
          rc[idx] = __builtin_amdgcn_cosf(fr); rsn[idx] = __builtin_amdgcn_sinf(fr); } }
#if PROBE
    if (blockIdx.x == 0 && tid == 0) ((unsigned long long*)ws)[101] = __builtin_amdgcn_s_memrealtime();
#endif
    constexpr int I_PW = 4 * 8, I_QKV = 16 * 48, I_DD = 16 * 32, I_KV = 16 * 64, I_UP = 16 * 128, I_DN = 64 * 32;
    constexpr int NITEMS = 4 * I_PW + I_QKV + I_DD + 2 * I_DD + 2 * I_KV + 2 * I_DD + 2 * I_UP + 2 * I_DN;
    for (int it = gw; it < NITEMS; it += NGW) {
        int r = it;
        if (r < 2 * I_UP) { const int L = r / I_UP; p0_transpose_item(KIN(16) + (size_t)L * D * FF, D, FF, (bf16_t*)(ws + WS_WUP) + (size_t)L * D * FF, KIN(15) + L * D, 0, scr, r % I_UP, lane); continue; } r -= 2 * I_UP;
        if (r < 2 * I_DN) { const int L = r / I_DN; p0_transpose_item(KIN(17) + (size_t)L * D * FF, FF, D, (bf16_t*)(ws + WS_WDN) + (size_t)L * D * FF, nullptr, 0, scr, r % I_DN, lane); continue; } r -= 2 * I_DN;
        if (r < 2 * I_KV) { const int L = r / I_KV; p0_transpose_item(KIN(13) + (size_t)L * D * 2 * D, D, 2 * D, (bf16_t*)(ws + WS_WXKV) + (size_t)L * D * 2 * D, KIN(11) + L * D, 0, scr, r % I_KV, lane); continue; } r -= 2 * I_KV;
        if (r < I_QKV) { p0_transpose_item(KIN(7), D, NQKV, (bf16_t*)(ws + WS_WQKV), KIN(4) + D, 1280, scr, r, lane); continue; } r -= I_QKV;
        if (r < I_DD) { p0_transpose_item(KIN(8), D, D, (bf16_t*)(ws + WS_WAO), nullptr, 0, scr, r, lane); continue; } r -= I_DD;
        if (r < 2 * I_DD) { const int L = r / I_DD; p0_transpose_item(KIN(12) + (size_t)L * D * D, D, D, (bf16_t*)(ws + WS_WXQ) + (size_t)L * D * D, KIN(10) + L * D, 0, scr, r % I_DD, lane); continue; } r -= 2 * I_DD;
        if (r < 2 * I_DD) { const int L = r / I_DD; p0_transpose_item(KIN(14) + (size_t)L * D * D, D, D, (bf16_t*)(ws + WS_WXO) + (size_t)L * D * D, nullptr, 0, scr, r % I_DD, lane); continue; } r -= 2 * I_DD;
        { const int gI = r / I_PW; p0_transpose_item(KIN(5) + (size_t)gI * 65536, 256, 256, (bf16_t*)(ws + WS_PW) + (size_t)gI * 65536, nullptr, 0, scr, r % I_PW, lane); }
    }
}

__device__ __forceinline__ void pool_phase(karg_t kp, LAS unsigned char* lds, int vcu, int G) {
    int tid_ = threadIdx.x; asm volatile("" : "+v"(tid_));
    const int tid = tid_, lane = tid & 63, wave = __builtin_amdgcn_readfirstlane(tid >> 6);
    bf16_t* diff = (bf16_t*)(KWS + WS_QB);
    const float* x0 = KIN(0); const float* x1 = KIN(1); const float* gmix = KIN(4);
    constexpr int NU = T / 32;
    f32x4 gm[4];
#pragma unroll
    for (int j = 0; j < 4; ++j) gm[j] = *((const f32x4*)gmix + lane + 64 * j);
    f32x4 pv[6][4];
#define POOL_FETCH(u) do { const int t0_ = (u) * 32; \
        const int s0_ = t0_ < TP ? (t0_ & ~(SEQP - 1)) : (t0_ & ~(SEQS - 1)), s1_ = s0_ + (t0_ < TP ? SEQP : SEQS); \
        _Pragma("unroll") for (int q = 0; q < 6; ++q) { const int grow = t0_ - 8 + wave * 6 + q; \
            if (grow >= s0_ && grow < s1_) { const float* src = (grow < TP) ? x0 + (size_t)grow * D : x1 + (size_t)(grow - TP) * D; \
                _Pragma("unroll") for (int j = 0; j < 4; ++j) pv[q][j] = *((const f32x4*)src + lane + 64 * j); } \
            else { _Pragma("unroll") for (int j = 0; j < 4; ++j) pv[q][j] = (f32x4){0.f, 0.f, 0.f, 0.f}; } } } while (0)
    if (vcu < NU) POOL_FETCH(vcu);
    __syncthreads();
    for (int u = vcu; u < NU; u += G) {
        const int t0 = u * 32;
        const int s0 = t0 < TP ? (t0 & ~(SEQP - 1)) : (t0 & ~(SEQS - 1)), s1 = s0 + (t0 < TP ? SEQP : SEQS);
#pragma unroll
        for (int q = 0; q < 6; ++q) {
            float ss = 0.f;
#pragma unroll
            for (int j = 0; j < 4; ++j) ss += (pv[q][j][0] * pv[q][j][0] + pv[q][j][1] * pv[q][j][1]) + (pv[q][j][2] * pv[q][j][2] + pv[q][j][3] * pv[q][j][3]);
            const float rs = rsqrtf(wave_sum(ss) * (1.0f / D) + EPS);
#pragma unroll
            for (int j = 0; j < 4; ++j) { const f32x4 h = pv[q][j] * rs * gm[j]; u32x2 w; w.x = pk_bf16(h[0], h[1]); w.y = pk_bf16(h[2], h[3]);
                *(LAS u32x2*)(lds + (wave * 6 + q) * 2048 + (lane + 64 * j) * 8) = w; }
        }
        WG_BAR_LDS();
        if (u + G < NU) POOL_FETCH(u + G);
        const int c2 = tid * 2, g = tid >> 7, hw = 1 << g;
        const LAS unsigned char* col = lds + c2 * 2;
#define POOL_LD(r) ({ const unsigned w_ = *(const LAS unsigned*)(col + (r) * 2048); (f32x2){__uint_as_float(w_ << 16), __uint_as_float(w_ & 0xffff0000u)}; })
        f32x2 sum = (f32x2){0.f, 0.f};
        for (int j = -hw; j < hw; ++j) sum += POOL_LD(8 + j);
        for (int r = 0; r < 32; ++r) {
            const int t = t0 + r;
            const int lo = max(t - hw, s0), hi2 = min(t + hw, s1);
            const f32x2 ctr = POOL_LD(r + 8);
            const float ic = 1.0f / (float)(hi2 - lo);
            *(unsigned*)(diff + (size_t)t * D + c2) = pk_bf16(sum[0] * ic - ctr[0], sum[1] * ic - ctr[1]);
            if (r < 31) sum += POOL_LD(r + 8 + hw) - POOL_LD(r + 8 - hw);
        }
        WG_BAR_LDS();
    }
#undef POOL_FETCH
#undef POOL_LD
}

__device__ __forceinline__ void final_phase(karg_t kp, int vcu, int G) {
    int tid_ = threadIdx.x; asm volatile("" : "+v"(tid_));
    const int tid = tid_, lane = tid & 63, wave = __builtin_amdgcn_readfirstlane(tid >> 6);
    const int gw = vcu * NWAVES + wave, NGW = G * NWAVES;
    const bf16_t* XB = (const bf16_t*)(KWS + WS_XB);
    f32x4 gn[4];
#pragma unroll
    for (int j = 0; j < 4; ++j) gn[j] = *((const f32x4*)KIN(18) + lane + 64 * j);
    u32x2 w[2][4];
#pragma unroll
    for (int q = 0; q < 2; ++q)
#pragma unroll
        for (int j = 0; j < 4; ++j) w[q][j] = *((const u32x2*)(XB + (size_t)(gw + q * NGW) * D) + lane + 64 * j);
    for (int m = gw; m < T; m += 2 * NGW) {
        const bool has = (m + 2 * NGW < T);
        u32x2 wn[2][4];
        if (has) {
#pragma unroll
            for (int q = 0; q < 2; ++q)
#pragma unroll
                for (int j = 0; j < 4; ++j) wn[q][j] = *((const u32x2*)(XB + (size_t)(m + 2 * NGW + q * NGW) * D) + lane + 64 * j);
        }
#pragma unroll
        for (int q = 0; q < 2; ++q) {
            f32x4 v[4]; float s = 0.f;
#pragma unroll
            for (int j = 0; j < 4; ++j) {
                v[j] = (f32x4){__uint_as_float(w[q][j].x << 16), __uint_as_float(w[q][j].x & 0xffff0000u), __uint_as_float(w[q][j].y << 16), __uint_as_float(w[q][j].y & 0xffff0000u)};
                s += (v[j][0] * v[j][0] + v[j][1] * v[j][1]) + (v[j][2] * v[j][2] + v[j][3] * v[j][3]);
            }
            const float rs = rsqrtf(wave_sum(s) * (1.0f / D) + EPS);
            f32x4* row = (f32x4*)(KOUT + (size_t)(m + q * NGW) * D);
#pragma unroll
            for (int j = 0; j < 4; ++j) __builtin_nontemporal_store(v[j] * rs * gn[j], row + lane + 64 * j);
        }
        if (has) {
#pragma unroll
            for (int q = 0; q < 2; ++q)
#pragma unroll
                for (int j = 0; j < 4; ++j) w[q][j] = wn[q][j];
        }
    }
}

#define XB_TMO      128
#define XB_XCNT(j)  (256  + 64 * (j))
#define XB_XSUB(j)  (1280 + 64 * (j))
#define XB_XGEN(j)  (2304 + 64 * (j))
#define XB_TOP      3328
#define XB_TOPGEN   3392
#define XCD_BAR_WORDS 3456
#define XB_SPIN_CAP (1u << 22)
__device__ __forceinline__ unsigned xb_ld(unsigned* p)              { return __hip_atomic_load(p, __ATOMIC_RELAXED, __HIP_MEMORY_SCOPE_AGENT); }
__device__ __forceinline__ unsigned xb_add(unsigned* p, unsigned v) { return __hip_atomic_fetch_add(p, v, __ATOMIC_RELAXED, __HIP_MEMORY_SCOPE_AGENT); }
__device__ __forceinline__ unsigned xb_xcc_id() { return (unsigned)__builtin_amdgcn_s_getreg((3 << 11) | 20) & 0xFu; }
#define XB_SPIN(cond, bar) do { unsigned _sp = 0; while (cond) { __builtin_amdgcn_s_sleep(1); \
    if ((++_sp & 255u) == 0u) { if (xb_ld(&(bar)[XB_TMO])) break; if (_sp > XB_SPIN_CAP) { atomicAdd(&(bar)[XB_TMO], 1u); break; } } } } while (0)
struct XcdBarrier { unsigned* bar; unsigned x; volatile LAS unsigned* st; };
__device__ __forceinline__ XcdBarrier xcd_barrier_post(unsigned* bar, volatile LAS unsigned* st) {
    XcdBarrier b; b.bar = bar; b.x = xb_xcc_id(); b.st = st;
    if (threadIdx.x == 0) (void)xb_add(&bar[XB_XCNT(b.x)], 1u);
    return b;
}
__device__ __forceinline__ void xcd_barrier_complete(unsigned* bar, unsigned x, unsigned& nloc, unsigned& nx) {
    const unsigned G = gridDim.x * gridDim.y * gridDim.z;
    unsigned sum, cnt, mine, sp = 0u;
    for (;;) {
        sum = 0u; cnt = 0u; mine = 0u;
#pragma unroll
        for (unsigned j = 0; j < 16; ++j) { const unsigned c = xb_ld(&bar[XB_XCNT(j)]); sum += c; cnt += (c > 0u) ? 1u : 0u; mine = (j == x) ? c : mine; }
        if (sum == G) break;
        __builtin_amdgcn_s_sleep(1);
        if ((++sp & 255u) == 0u) { if (xb_ld(&bar[XB_TMO])) break; if (sp > XB_SPIN_CAP) { atomicAdd(&bar[XB_TMO], 1u); break; } }
    }
    nloc = mine > 0u ? mine : 1u; nx = cnt > 0u ? cnt : 1u;
}
__device__ __forceinline__ void xcd_barrier(const XcdBarrier& b) {
    asm volatile("s_waitcnt vmcnt(0)" ::: "memory");
    __syncthreads();
    if (threadIdx.x == 0) {
        unsigned* bar = b.bar;
        __builtin_amdgcn_s_waitcnt(0);
        unsigned nloc = b.st[0], nx = b.st[1];
        if (nloc == 0u) { xcd_barrier_complete(bar, b.x, nloc, nx); b.st[0] = nloc; b.st[1] = nx; }
        const unsigned old = xb_add(&bar[XB_XSUB(b.x)], 1u);
        const unsigned gen = old / nloc;
        if (old + 1u == (gen + 1u) * nloc) {
            __builtin_amdgcn_fence(__ATOMIC_RELEASE, "agent");
            asm volatile("s_waitcnt vmcnt(0)" ::: "memory");
            const unsigned og = xb_add(&bar[XB_TOP], 1u);
            const unsigned tg = og / nx;
            if (og + 1u == (tg + 1u) * nx) xb_add(&bar[XB_TOPGEN], 1u);
            else XB_SPIN(xb_ld(&bar[XB_TOPGEN]) == tg, bar);
            __builtin_amdgcn_fence(__ATOMIC_ACQUIRE, "agent");
            xb_add(&bar[XB_XGEN(b.x)], 1u);
            asm volatile("s_waitcnt vmcnt(0)" ::: "memory");
        } else {
            XB_SPIN(xb_ld(&bar[XB_XGEN(b.x)]) == gen, bar);
            __builtin_amdgcn_fence(__ATOMIC_ACQUIRE, "agent");
            asm volatile("s_waitcnt vmcnt(0)" ::: "memory");
        }
    }
    __syncthreads();
}
constexpr size_t WS_BAR = 16384;
constexpr int LDS_MISC = 131072 + 1024, LDS_RED = 131072 + 4096;

enum { K_PRO = 0, K_POOL, K_G_RESID, K_G_ROW, K_G_UP, K_G_QKV, K_XATT, K_WATT, K_FINAL };
constexpr int NSTEPS = 28;
struct Step {
    int kind, sync;
    pg8::Gemm g;
    const float* base_lo; const float* base_hi; int split_row; int base_f32; const float* cscale;
    bf16_t* out; int ldc; const float* ssp; float cst; int tsplit; bf16_t* vt; int t_pm_stride, t_ld;
    int layer;
};

__device__ __forceinline__ Step make_step(int vs, karg_t kp) {
    unsigned char* ws = KWS;
    const bool partB = (vs == 15); const int st = partB ? 4 : (vs < 15 ? vs : vs - 1);
    Step s; s.kind = K_PRO; s.sync = 1; s.g = pg8::Gemm{nullptr, nullptr, D, D, D, 0, 0, 0, 0};
    s.base_lo = nullptr; s.base_hi = nullptr; s.split_row = 1 << 30; s.base_f32 = 0; s.cscale = nullptr;
    s.out = nullptr; s.ldc = D; s.ssp = (const float*)(ws + WS_SSP); s.cst = 1.f; s.tsplit = 1 << 20; s.vt = nullptr; s.t_pm_stride = 0; s.t_ld = 0; s.layer = 0;
    bf16_t* XB = (bf16_t*)(ws + WS_XB); bf16_t* QB = (bf16_t*)(ws + WS_QB);
    int mlp = -1, xa = -1;
    if (st == 0) { s.kind = K_PRO; s.sync = 0; }
    else if (st == 1) { s.kind = K_POOL; }
    else if (st == 2) { s.kind = K_G_RESID; s.sync = 0; s.g = pg8::Gemm{QB, (const bf16_t*)(ws + WS_PW), D, 256, 256, 256, T / 256, 4, 0};
        s.base_lo = KIN(0); s.base_hi = KIN(1); s.split_row = TP; s.base_f32 = 1; s.cscale = KIN(6); }
    else if (st == 3 || st == 4) { const int L = st - 3; s.kind = K_G_ROW; s.sync = (st == 4); s.layer = L;
        s.g = pg8::Gemm{(const bf16_t*)(ws + WS_MB), (const bf16_t*)(ws + WS_WXKV) + (size_t)L * 2 * D * D, D, D, D, 0, NMEMROWS / 256, 8, 0};
        s.out = (bf16_t*)(ws + WS_KM) + (size_t)L * NMEMROWS * D; s.ldc = D; s.ssp = (const float*)(ws + WS_SSPM); s.cst = 1.f; s.tsplit = 4;
        s.vt = (bf16_t*)(ws + WS_VMT) + (size_t)L * NMEMROWS * D; s.t_pm_stride = D * 256; s.t_ld = 256;
        if (L == 1) { if (partB) { s.g.u_lo = 0; s.g.u_cnt = 128; s.g.c_rot = 128; s.sync = 1; } else { s.g.u_lo = 128; s.g.u_cnt = 16; s.g.c_rot = 144; } } }
    else if (st >= 5 && st <= 7) { xa = st - 5; s.layer = 0; }
    else if (st >= 8 && st <= 13) { mlp = st - 8; s.layer = 0; }
    else if (st == 14) { s.kind = K_G_QKV; s.sync = 0; s.g = pg8::Gemm{XB, (const bf16_t*)(ws + WS_WQKV), D, D, D, 0, T / 256, 6, 0}; }
    else if (st == 15) { s.kind = K_WATT; }
    else if (st == 16) { s.kind = K_G_RESID; s.g = pg8::Gemm{QB, (const bf16_t*)(ws + WS_WAO), D, D, D, 0, T / 256, 4, 0}; }
    else if (st >= 17 && st <= 19) { xa = st - 17; s.layer = 1; }
    else if (st >= 20 && st <= 25) { mlp = st - 20; s.layer = 1; }
    else { s.kind = K_FINAL; s.sync = 0; }
    if (xa == 0) { s.kind = K_G_ROW; s.g = pg8::Gemm{XB, (const bf16_t*)(ws + WS_WXQ) + (size_t)s.layer * D * D, D, D, D, 0, T / 256, 4, 0};
        s.out = QB; s.ldc = D; s.cst = 0.0625f * LOG2E; s.sync = 0; }
    else if (xa == 1) { s.kind = K_XATT; }
    else if (xa == 2) { s.kind = K_G_RESID; s.g = pg8::Gemm{QB, (const bf16_t*)(ws + WS_WXO) + (size_t)s.layer * D * D, D, D, D, 0, T / 256, 4, 0}; }
    if (mlp >= 0) {
        const int c = mlp >> 1, pm0 = 64 * c;
        bf16_t* H = (bf16_t*)(ws + ((c & 1) ? WS_H1 : WS_H0)) - (size_t)pm0 * 256 * FF;
        if ((mlp & 1) == 0) { s.kind = K_G_UP; s.sync = 1; s.g = pg8::Gemm{XB, (const bf16_t*)(ws + WS_WUP) + (size_t)s.layer * D * FF, D, D, D, 0, 64, 16, pm0}; s.out = H; }
        else { s.kind = K_G_RESID; s.sync = (c == 2); s.g = pg8::Gemm{H, (const bf16_t*)(ws + WS_WDN) + (size_t)s.layer * D * FF, FF, FF, FF, 0, 64, 4, pm0}; }
    }
    return s;
}

__global__ void __launch_bounds__(NTHR, 2) fwd_megakernel(Args a) {
    __builtin_assume(__builtin_amdgcn_workitem_id_y() == 0); __builtin_assume(__builtin_amdgcn_workitem_id_z() == 0);
    extern __shared__ __attribute__((aligned(16))) unsigned char lds_raw[];
    LAS unsigned char* lds = (LAS unsigned char*)lds_raw;
    karg_t kp = (karg_t)__builtin_amdgcn_kernarg_segment_ptr();
    const int G = gridDim.x, bx = blockIdx.x;
    const int vcu = (G % 8 == 0) ? (bx % 8) * (G / 8) + bx / 8 : bx;
    unsigned char* ws = KWS;
    volatile LAS unsigned* misc = (volatile LAS unsigned*)(lds + LDS_MISC);
    if (threadIdx.x < 2) misc[threadIdx.x] = 0u;
    __syncthreads();
    XcdBarrier bar = xcd_barrier_post((unsigned*)(ws + WS_BAR), misc);
#if PROBE
    unsigned long long* tsb = (unsigned long long*)ws;
#endif
    for (int st = a.lo; st < a.hi; ++st) {
        asm volatile("" : "+s"(kp));
        const Step s = make_step(st, kp);
#if PROBE
        if (bx == 0 && threadIdx.x == 0) tsb[2 * st] = __builtin_amdgcn_s_memrealtime();
#endif
        switch (s.kind) {
        case K_PRO: prologue_phase(kp, lds, vcu, G); break;
        case K_POOL: pool_phase(kp, lds, vcu, G); break;
        case K_G_RESID: { pg8::EpiResid E{s.base_lo, s.base_hi, s.split_row, s.base_f32, (bf16_t*)(ws + WS_XB), (float*)(ws + WS_SSP), s.cscale, (LAS float*)(lds + LDS_RED)};
            pg8::gemm_phase<pg8::EpiResid>(lds, s.g, G, bx, E); } break;
        case K_G_ROW: { pg8::EpiRowScale E{s.out, s.ldc, s.ssp, s.cst, s.tsplit, s.vt, s.t_pm_stride, s.t_ld};
            pg8::gemm_phase<pg8::EpiRowScale>(lds, s.g, G, bx, E); } break;
        case K_G_UP: { pg8::EpiUp E{s.out, s.ssp};
            pg8::gemm_phase<pg8::EpiUp>(lds, s.g, G, bx, E); } break;
        case K_G_QKV: { pg8::EpiQKV E{(bf16_t*)(ws + WS_QB), (bf16_t*)(ws + WS_KW), (bf16_t*)(ws + WS_VT), (const float*)(ws + WS_SSP), (const float*)(ws + WS_ROPE), (const float*)(ws + WS_ROPE) + SEQS * 32};
            pg8::gemm_phase<pg8::EpiQKV>(lds, s.g, G, bx, E); } break;
        case K_XATT: {
            const bf16_t* KM = (const bf16_t*)(ws + WS_KM) + (size_t)s.layer * NMEMROWS * D; const bf16_t* VMT = (const bf16_t*)(ws + WS_VMT) + (size_t)s.layer * NMEMROWS * D;
            __builtin_amdgcn_fence(__ATOMIC_ACQUIRE, "agent");
            pg8::Gemm gq{nullptr, nullptr, D, D, D, 0, T / 256, 4, 0};
            pg8::Order S; S.init(gq, G, bx);
            pg8::Unit u;
            for (int i = 0; S.next(i, u); ++i) xattn_unit(lds, (bf16_t*)(ws + WS_QB), KM, VMT, u.pm, u.pn);
        } break;
        case K_WATT: {
            wattn_phase(lds, (bf16_t*)(ws + WS_QB), (const bf16_t*)(ws + WS_KW), (const bf16_t*)(ws + WS_VT), KIN(9), vcu, G);
        } break;
        default: final_phase(kp, vcu, G); break;
        }
#if PROBE
        __syncthreads();
        if (bx == 0 && threadIdx.x == 0) tsb[2 * st + 1] = __builtin_amdgcn_s_memrealtime();
#endif
        if (s.sync && st + 1 < a.hi) { if (a.hi < 0) cg::this_grid().sync(); else xcd_barrier(bar); }
    }
#if PROBE
    cg::this_grid().sync();
    if (bx == 0 && threadIdx.x == 0) {
        const unsigned long long tend = __builtin_amdgcn_s_memrealtime();
        unsigned long long sa = 0, sa2 = 0, sb = 0;
        for (int st = 0; st < NSTEPS; ++st) {
            const unsigned long long w = tsb[2 * st + 1] - tsb[2 * st], y = (st + 1 < NSTEPS ? tsb[2 * st + 2] : tend) - tsb[2 * st + 1];
            if ((P_A1W >> st) & 1ull) sa += w; if ((P_A2W >> st) & 1ull) sa2 += w; if ((P_A1S >> st) & 1ull) sa += y; if ((P_A2S >> st) & 1ull) sa2 += y;
            if ((P_BW >> st) & 1ull) sb += w; if ((P_BS >> st) & 1ull) sb += y;
        }
#if PROBE_SET == 9
        sa = tsb[100] - tsb[0]; sa2 = tsb[101] - tsb[100];
#endif
#if PROBE_SET == 13
        sa = tsb[2 * (NSTEPS - 1) + 1] - tsb[0]; sa2 = 0;
#endif
        const float ta = (float)sa * 0.01f, ta2 = (float)sa2 * 0.01f;
        KOUT[0] += sqrtf(ta * 2.5e-8f * 33554432.f); KOUT[(size_t)TP * D] += sqrtf(ta * 2.5e-8f * 16777216.f);
        KOUT[1] += sqrtf(ta2 * 2.5e-8f * 33554432.f); KOUT[(size_t)TP * D + 1] += sqrtf(ta2 * 2.5e-8f * 16777216.f);
        const unsigned long long t0 = __builtin_amdgcn_s_memrealtime();
        while (__builtin_amdgcn_s_memrealtime() - t0 < sb) __builtin_amdgcn_s_sleep(8);
    }
#endif
}

constexpr int LDS_BYTES = 147456;
extern "C" void kernel_launch(void* const* d_in, const int* in_sizes, int n_in, void* d_out, int out_size, void* d_ws, size_t ws_size, hipStream_t stream) {
    static int grid = 0;
    if (grid == 0) {
        if (n_in != 19 || out_size != T * D || ws_size < WS_END) { fprintf(stderr, "kernel_launch: unexpected problem (n_in %d, out %d, ws %zu); nothing launched\n", n_in, out_size, ws_size); grid = -1; return; }
        int dev = 0, cus = 0, per_cu = 0;
        hipGetDevice(&dev); hipDeviceGetAttribute(&cus, hipDeviceAttributeMultiprocessorCount, dev);
        if (hipFuncSetAttribute((const void*)fwd_megakernel, hipFuncAttributeMaxDynamicSharedMemorySize, LDS_BYTES) != hipSuccess) { fprintf(stderr, "kernel_launch: hipFuncSetAttribute failed\n"); grid = -1; return; }
        if (hipOccupancyMaxActiveBlocksPerMultiprocessor(&per_cu, (const void*)fwd_megakernel, NTHR, LDS_BYTES) != hipSuccess || per_cu < 1) { fprintf(stderr, "kernel_launch: occupancy query says %d\n", per_cu); per_cu = 1; }
        (void)hipGetLastError();
        grid = cus * per_cu;
        fprintf(stderr, "kernel_launch: grid %d (%d CUs x %d)\n", grid, cus, per_cu);
    }
    if (grid < 0) return;
    if (hipMemsetAsync(d_ws, 0, 65536, stream) != hipSuccess) { fprintf(stderr, "kernel_launch: memset failed\n"); return; }
    Args a{};
    for (int i = 0; i < 19; ++i) a.in[i] = (const float*)d_in[i];
    a.out = (float*)d_out; a.ws = (unsigned char*)d_ws;
#if ONE_LAUNCH
    a.lo = 0; a.hi = NSTEPS;
    void* args[] = {&a};
    hipError_t e = hipLaunchCooperativeKernel((const void*)fwd_megakernel, dim3(grid), dim3(NTHR), args, LDS_BYTES, stream);
    if (e != hipSuccess) fprintf(stderr, "kernel_launch: cooperative launch failed: %s (grid %d)\n", hipGetErrorString(e), grid);
#else
    for (int st = 0; st < NSTEPS; ++st) {
        a.lo = st; a.hi = st + 1;
        hipLaunchKernelGGL(fwd_megakernel, dim3(grid), dim3(NTHR), LDS_BYTES, stream, a);
    }
#endif
}
```
